# Optimizing an MI355X kernel written in HIP

```python
import math
import jax
import jax.numpy as jnp
from jax import lax
import numpy as np

D_MODEL = 1024
BATCH = 16
SEQ = 2048
DEPTH = 1

CHUNK = 64
EPS = 1e-6
NEG_INF = -1e30

A_HEADS = 8
A_HEAD_DIM = 64
A_WIDTH = A_HEADS * A_HEAD_DIM
A_LEFT_CHUNKS = 8
A_BAND = A_LEFT_CHUNKS + 1
REL_CLIP = 128

B_HEADS = 8
B_HEAD_DIM = 128
B_WIDTH = B_HEADS * B_HEAD_DIM
CONV_WIDTH = 4
DT_MIN = 0.001
DT_MAX = 0.1

N_BRANCHES = 2

IN_SPLITS = (A_WIDTH, A_WIDTH, A_WIDTH, 3 * B_WIDTH, B_HEADS, B_HEADS, B_WIDTH, N_BRANCHES * D_MODEL)
IN_WIDTH = sum(IN_SPLITS)
IN_OFFSETS = tuple(int(o) for o in np.cumsum(IN_SPLITS)[:-1])

PEER_HEADS = 8
PEER_QDIM = 256
PEER_HALF = PEER_QDIM // 2
PEER_NKEYS = 128
PEER_N_EXPERTS = PEER_NKEYS * PEER_NKEYS
PEER_TOPK = 16
PEER_BLOCK = 128

kernel_name = 'hybrid_chunkattn_gdn_peer_block'


def rms_norm(x, w):
    xf = x.astype(jnp.float32)
    y = xf * lax.rsqrt(jnp.mean(xf * xf, axis=-1, keepdims=True) + EPS)
    return (y * w.astype(jnp.float32)).astype(x.dtype)


def l2_normalize(t):
    return t * lax.rsqrt(jnp.sum(t * t, axis=-1, keepdims=True) + EPS)


def chunk_band_attention(q, k, v, q_norm_w, k_norm_w, rel_bias):
    b, s, _ = q.shape
    n = s // CHUNK
    shp = (b, n, CHUNK, A_HEADS, A_HEAD_DIM)
    q = rms_norm(q.reshape(shp), q_norm_w)
    k = rms_norm(k.reshape(shp), k_norm_w)
    v = v.reshape(shp)
    pad = ((0, 0), (A_LEFT_CHUNKS, 0), (0, 0), (0, 0), (0, 0))
    band = jnp.arange(n)[:, None] + jnp.arange(A_BAND)[None, :]
    kb = jnp.pad(k, pad)[:, band].reshape(b, n, A_BAND * CHUNK, A_HEADS, A_HEAD_DIM)
    vb = jnp.pad(v, pad)[:, band].reshape(b, n, A_BAND * CHUNK, A_HEADS, A_HEAD_DIM)
    scores = jnp.einsum('bnihd,bnjhd->bnhij', q, kb).astype(jnp.float32) * (A_HEAD_DIM ** -0.5)
    qpos = A_LEFT_CHUNKS * CHUNK + jnp.arange(CHUNK)
    kpos = jnp.arange(A_BAND * CHUNK)
    rel = jnp.clip(qpos[:, None] - kpos[None, :], -REL_CLIP, REL_CLIP) + REL_CLIP
    bias = rel_bias.astype(jnp.float32)[:, rel]
    valid = jnp.repeat(band >= A_LEFT_CHUNKS, CHUNK, axis=1)
    scores = jnp.where(valid[None, :, None, None, :], scores + bias[None, None], NEG_INF)
    probs = jax.nn.softmax(scores, axis=-1).astype(v.dtype)
    out = jnp.einsum('bnhij,bnjhd->bnihd', probs, vb)
    return out.reshape(b, s, A_WIDTH)


def causal_short_conv(x, w):
    s = x.shape[1]
    xp = jnp.pad(x, ((0, 0), (CONV_WIDTH - 1, 0), (0, 0)))
    return sum(xp[:, i:i + s] * w[i] for i in range(CONV_WIDTH))


def chunk_gated_delta_rule(q, k, v, g, beta):
    c = q.shape[3]
    tri_incl = jnp.tril(jnp.ones((c, c), dtype=bool))
    tri_strict = jnp.tril(jnp.ones((c, c), dtype=bool), -1)
    eye = jnp.eye(c, dtype=jnp.float32)
    g_cum = jnp.cumsum(g, axis=-1)
    decay = jnp.exp(jnp.where(tri_incl, g_cum[..., :, None] - g_cum[..., None, :], -jnp.inf))
    k_beta = k * beta[..., None]
    v_beta = v * beta[..., None]
    a_mat = jnp.where(tri_strict, jnp.einsum('bhnid,bhnjd->bhnij', k_beta, k) * decay, 0.0)
    t_mat = lax.linalg.triangular_solve(eye + a_mat, jnp.broadcast_to(eye, a_mat.shape),
                                        left_side=True, lower=True)
    u = jnp.einsum('bhnij,bhnje->bhnie', t_mat, v_beta)
    w = jnp.einsum('bhnij,bhnjd->bhnid', t_mat, k_beta * jnp.exp(g_cum)[..., None])
    attn_intra = jnp.where(tri_incl, jnp.einsum('bhnid,bhnjd->bhnij', q, k) * decay, 0.0)
    g_last = g_cum[..., -1]
    k_dec = k * jnp.exp(g_last[..., None] - g_cum)[..., None]
    q_dec = q * jnp.exp(g_cum)[..., None]

    def step(state, inp):
        qd, kd, w_c, u_c, attn_c, gl = inp
        v_new = u_c - jnp.einsum('bhcd,bhde->bhce', w_c, state)
        o = jnp.einsum('bhcd,bhde->bhce', qd, state) + jnp.einsum('bhij,bhje->bhie', attn_c, v_new)
        state = state * jnp.exp(gl)[..., None, None] + jnp.einsum('bhcd,bhce->bhde', kd, v_new)
        return state, o

    xs = tuple(jnp.moveaxis(t, 2, 0) for t in (q_dec, k_dec, w, u, attn_intra, g_last))
    b, h = q.shape[0], q.shape[1]
    s0 = jnp.zeros((b, h, q.shape[-1], v.shape[-1]), jnp.float32)
    _, o = lax.scan(step, s0, xs)
    return jnp.moveaxis(o, 0, 2)


def gated_deltanet(qkv_raw, a_raw, beta_raw, gate_raw, conv_w, a_log, dt_bias, norm_w):
    b, s, _ = qkv_raw.shape
    n = s // CHUNK
    f32 = jnp.float32
    qkv = jax.nn.silu(causal_short_conv(qkv_raw, conv_w)).astype(f32)
    q, k, v = jnp.split(qkv, 3, axis=-1)

    def to_chunks(t):
        return t.reshape(b, n, CHUNK, B_HEADS, B_HEAD_DIM).transpose(0, 3, 1, 2, 4)

    def heads_to_chunks(t):
        return t.reshape(b, n, CHUNK, B_HEADS).transpose(0, 3, 1, 2)

    q = l2_normalize(to_chunks(q)) * (B_HEAD_DIM ** -0.5)
    k = l2_normalize(to_chunks(k))
    v = to_chunks(v)
    beta = heads_to_chunks(jax.nn.sigmoid(beta_raw.astype(f32)))
    g = heads_to_chunks(-jnp.exp(a_log.astype(f32)) * jax.nn.softplus(a_raw.astype(f32) + dt_bias.astype(f32)))
    o = chunk_gated_delta_rule(q, k, v, g, beta)
    o = o.transpose(0, 2, 3, 1, 4).reshape(b, s, B_HEADS, B_HEAD_DIM)
    o = rms_norm(o, norm_w) * jax.nn.silu(gate_raw.astype(f32).reshape(b, s, B_HEADS, B_HEAD_DIM))
    return o.reshape(b, s, B_WIDTH).astype(qkv_raw.dtype)


def peer_ffn(h, w_query, keys_1, keys_2, expert_down, expert_up):
    b, s, d = h.shape
    hb = h.reshape((b * s) // PEER_BLOCK, PEER_BLOCK, d)

    def block(xt):
        q = (xt @ w_query).reshape(PEER_BLOCK, PEER_HEADS, PEER_QDIM)
        s1 = jnp.einsum('phd,hkd->phk', q[..., :PEER_HALF], keys_1).astype(jnp.float32)
        s2 = jnp.einsum('phd,hkd->phk', q[..., PEER_HALF:], keys_2).astype(jnp.float32)
        v1, i1 = lax.top_k(s1, PEER_TOPK)
        v2, i2 = lax.top_k(s2, PEER_TOPK)
        cand = (v1[..., :, None] + v2[..., None, :]).reshape(PEER_BLOCK, PEER_HEADS, PEER_TOPK * PEER_TOPK)
        cand_idx = (i1[..., :, None] * PEER_NKEYS + i2[..., None, :]).reshape(PEER_BLOCK, PEER_HEADS, PEER_TOPK * PEER_TOPK)
        top_s, pos = lax.top_k(cand, PEER_TOPK)
        expert_idx = jnp.take_along_axis(cand_idx, pos, axis=-1)
        gate = jax.nn.softmax(top_s, axis=-1)
        u = expert_down[expert_idx]
        act = jax.nn.gelu(jnp.einsum('pd,phkd->phk', xt, u).astype(jnp.float32), approximate=False)
        vv = expert_up[expert_idx]
        return jnp.einsum('phk,phkd->pd', (gate * act).astype(xt.dtype), vv)

    return lax.map(block, hb).reshape(b, s, d)


def hybrid_layer(x, norm_mix_w, w_in, a_q_norm_w, a_k_norm_w, a_rel_bias, b_conv_w, b_a_log,
                 b_dt_bias, b_norm_w, b_merge, w_proj_a, w_proj_b, w_out, norm_ffn_w,
                 peer_w_query, peer_keys_1, peer_keys_2, peer_down, peer_up):
    b, s, _ = x.shape
    h = rms_norm(x, norm_mix_w)
    z = h @ w_in
    qa, ka, va, qkv_b, a_b, beta_b, gate_b, merge_raw = jnp.split(z, IN_OFFSETS, axis=-1)
    o_a = chunk_band_attention(qa, ka, va, a_q_norm_w, a_k_norm_w, a_rel_bias)
    o_b = gated_deltanet(qkv_b, a_b, beta_b, gate_b, b_conv_w, b_a_log, b_dt_bias, b_norm_w)
    gates = jax.nn.sigmoid(merge_raw.astype(jnp.float32) + b_merge.astype(jnp.float32))
    gates = gates.reshape(b, s, N_BRANCHES, D_MODEL).astype(x.dtype)
    mixed = gates[..., 0, :] * (o_a @ w_proj_a) + gates[..., 1, :] * (o_b @ w_proj_b)
    x = x + mixed @ w_out
    x = x + peer_ffn(rms_norm(x, norm_ffn_w), peer_w_query, peer_keys_1, peer_keys_2, peer_down, peer_up)
    return x


def setup_inputs(seed: int = 0) -> dict:
    key = jax.random.key(seed)
    ks = jax.random.split(key, 20)
    f32 = jnp.float32
    L = DEPTH

    def nrm(k, shape, scale):
        return jax.random.normal(k, shape, f32) * scale

    def gain(k, n):
        return 1.0 + 0.02 * jax.random.normal(k, (L, n), f32)

    dt = jnp.exp(jax.random.uniform(ks[7], (L, B_HEADS), f32, math.log(DT_MIN), math.log(DT_MAX)))
    return {
        'x': nrm(ks[0], (BATCH, SEQ, D_MODEL), 1.0),
        'norm_mix_w': gain(ks[1], D_MODEL),
        'w_in': nrm(ks[2], (L, D_MODEL, IN_WIDTH), D_MODEL ** -0.5),
        'a_q_norm_w': gain(ks[3], A_HEAD_DIM),
        'a_k_norm_w': gain(ks[4], A_HEAD_DIM),
        'a_rel_bias': nrm(ks[5], (L, A_HEADS, 2 * REL_CLIP + 1), 0.5),
        'b_conv_w': nrm(ks[6], (L, CONV_WIDTH, 3 * B_WIDTH), CONV_WIDTH ** -0.5),
        'b_a_log': jnp.log(jax.random.uniform(ks[8], (L, B_HEADS), f32, 1.0, 16.0)),
        'b_dt_bias': dt + jnp.log(-jnp.expm1(-dt)),
        'b_norm_w': gain(ks[9], B_HEAD_DIM),
        'b_merge': nrm(ks[10], (L, N_BRANCHES * D_MODEL), 0.02),
        'w_proj_a': nrm(ks[11], (L, A_WIDTH, D_MODEL), A_WIDTH ** -0.5),
        'w_proj_b': nrm(ks[12], (L, B_WIDTH, D_MODEL), B_WIDTH ** -0.5),
        'w_out': nrm(ks[13], (L, D_MODEL, D_MODEL), D_MODEL ** -0.5),
        'norm_ffn_w': gain(ks[14], D_MODEL),
        'peer_w_query': nrm(ks[15], (L, D_MODEL, PEER_HEADS * PEER_QDIM), D_MODEL ** -0.5),
        'peer_keys_1': nrm(ks[16], (L, PEER_HEADS, PEER_NKEYS, PEER_HALF), PEER_HALF ** -0.5),
        'peer_keys_2': nrm(ks[17], (L, PEER_HEADS, PEER_NKEYS, PEER_HALF), PEER_HALF ** -0.5),
        'peer_down': nrm(ks[18], (L, PEER_N_EXPERTS, D_MODEL), D_MODEL ** -0.5),
        'peer_up': nrm(ks[19], (L, PEER_N_EXPERTS, D_MODEL), PEER_HEADS ** -0.5),
    }


def reference(x, norm_mix_w, w_in, a_q_norm_w, a_k_norm_w, a_rel_bias, b_conv_w, b_a_log,
              b_dt_bias, b_norm_w, b_merge, w_proj_a, w_proj_b, w_out, norm_ffn_w,
              peer_w_query, peer_keys_1, peer_keys_2, peer_down, peer_up):
    for l in range(DEPTH):
        x = hybrid_layer(x, norm_mix_w[l], w_in[l], a_q_norm_w[l], a_k_norm_w[l], a_rel_bias[l],
                         b_conv_w[l], b_a_log[l], b_dt_bias[l], b_norm_w[l], b_merge[l],
                         w_proj_a[l], w_proj_b[l], w_out[l], norm_ffn_w[l], peer_w_query[l],
                         peer_keys_1[l], peer_keys_2[l], peer_down[l], peer_up[l])
    return x
```

```cpp
#include <hip/hip_runtime.h>
#include <cstdio>
#include <cstdint>
namespace pg8 {
#define PG8_LAS __attribute__((address_space(3)))
typedef unsigned short bf16_t;
typedef short bf16x8 __attribute__((ext_vector_type(8)));
typedef float f32x4 __attribute__((ext_vector_type(4)));
typedef unsigned u32x4 __attribute__((ext_vector_type(4)));
constexpr int BM = 256, BK = 64, HALF = 128, HTB = HALF * BK * 2  , STAGE_BYTES = 8 * HTB, NXCD = 8, WGM = 8;

__host__ __device__ __forceinline__ int lds_byte(int r, int c) { const int st = (r >> 4) * 2 + (c >> 5), rr = r & 15, cc = c & 31, ob = rr * 64 + cc * 2; return st * 1024 + (ob ^ (((ob >> 9) & 1) << 5)); }
__host__ __device__ __forceinline__ void stage_rc(int b, int& R, int& C) { const int st = b / 1024, sb = b % 1024, swz = sb ^ (((sb >> 9) & 1) << 5); R = (st >> 1) * 16 + swz / 64; C = (st & 1) * 32 + (swz % 64) / 2; }
__host__ __device__ __forceinline__ int perm32(int rho) { const int n = rho >> 4, i = rho & 15; return 8 * (i >> 2) + 4 * n + (i & 3); }

struct Unit { int pm, pn; };
struct Gemm { const bf16_t* A; const bf16_t* Bt; int M, N, K; };

struct StaticOrder {
    int nM, nN, nwg, G, c;
    __host__ __device__ void init(int M, int N, int G_, int c_) { nM = M / BM; nN = N / BM; nwg = nM * nN; G = G_; c = c_; }
    __host__ __device__ bool next(int i, Unit& u) const {
        const long L = (long)i * G + c; if (L >= nwg) return false;
        int wgid = (int)L; { const int q = nwg / NXCD, r = nwg % NXCD, xcd = wgid % NXCD, off = wgid / NXCD; wgid = (xcd < r ? xcd * (q + 1) : r * (q + 1) + (xcd - r) * q) + off; }
        const int nig = WGM * nN, gid = wgid / nig, fm = gid * WGM, gsz = (nM - fm) < WGM ? (nM - fm) : WGM;
        u.pm = fm + ((wgid % nig) % gsz); u.pn = (wgid % nig) / gsz; return true;
    }
    __device__ __forceinline__ void a_ready(const Unit&) const {}
    __device__ __forceinline__ void done(const Unit&) const {}
};

__device__ __forceinline__ unsigned cvt_pk_bf16(float lo, float hi) { unsigned r; asm volatile("v_cvt_pk_bf16_f32 %0, %1, %2" : "=v"(r) : "v"(lo), "v"(hi)); return r; }
typedef float f32x2 __attribute__((ext_vector_type(2)));
__device__ __forceinline__ const char* pg8_uptr(const char* p) { const unsigned long long v = (unsigned long long)p; const unsigned lo = (unsigned)__builtin_amdgcn_readfirstlane((int)(unsigned)v), hi = (unsigned)__builtin_amdgcn_readfirstlane((int)(unsigned)(v >> 32)); return (const char*)(((unsigned long long)hi << 32) | lo); }
typedef int v8i_t __attribute__((ext_vector_type(8))); typedef int v4i_t __attribute__((ext_vector_type(4)));
template <class Epi, class Sched, bool ALIGN_EPI = false, bool SP2 = false, bool FP8 = false>
__device__ __forceinline__ void gemm_phase(PG8_LAS unsigned char* lds, const Gemm g, const Sched& S, const Epi& E, const int wid  ) {
    int lane_ = (int)__builtin_amdgcn_mbcnt_hi(~0u, __builtin_amdgcn_mbcnt_lo(~0u, 0u)); asm volatile("" : "+v"(lane_));
    const int lane = lane_, tid = wid * 64 + lane,     wr = wid >> 2, wc = wid & 3, fr = lane & 15, fq = lane >> 4;
    const int K = g.K, nt = K / BK;
    unsigned voffA[2], voffB[2];
#pragma unroll
    for (int i = 0; i < 2; ++i) { int R, C; stage_rc(tid * 16 + i * 8192, R, C); const int Rb = Epi::PERM ? ((R & ~31) + perm32(R & 31)) : R;
        voffA[i] = (unsigned)(R * K + C) * 2u; voffB[i] = (unsigned)(Rb * K + C) * 2u; }
    const size_t kstep = (size_t)(BK * 2);
    const size_t hstep = (size_t)HALF * K * 2;
    const size_t tstep = 2 * hstep;
    const unsigned ldsw = (unsigned)wid * 1024u;
    const int aoff = lds_byte(wr * 64 + fr, fq * 8), boff = lds_byte(wc * 32 + fr, fq * 8);
#define PG8_SA(b, h) (((b) * 2 + (h)) * HTB)
#define PG8_SB(b, h) ((4 + (b) * 2 + (h)) * HTB)
#define PG8_STAGE(bufoff, gbase, voff) do { const char* gb_ = pg8_uptr((const char*)(gbase)); _Pragma("unroll") for (int _i = 0; _i < 2; ++_i) \
        __builtin_amdgcn_global_load_lds((const unsigned*)(gb_ + (voff)[_i]), (PG8_LAS unsigned*)(lds + (bufoff) + ldsw + _i * 8192), 16, 0, 0); } while (0)
#define PG8_LDA(dst, b, h) do { if constexpr (FP8) { _Pragma("unroll") for (int m = 0; m < 4; ++m) dst##8[m] = PG8_CAT(*(const PG8_LAS v4i_t*)(lds + PG8_SA(b, h) + aoff + m * 2048), *(const PG8_LAS v4i_t*)(lds + PG8_SA(b, h) + aoff + m * 2048 + 1024)); } \
        else { _Pragma("unroll") for (int m = 0; m < 4; ++m) _Pragma("unroll") for (int k = 0; k < 2; ++k) dst[m][k] = *(const PG8_LAS bf16x8*)(lds + PG8_SA(b, h) + aoff + m * 2048 + k * 1024); } } while (0)
#define PG8_LDB(dst, b, h) do { if constexpr (FP8) { _Pragma("unroll") for (int n = 0; n < 2; ++n) dst##8[n] = PG8_CAT(*(const PG8_LAS v4i_t*)(lds + PG8_SB(b, h) + boff + n * 2048), *(const PG8_LAS v4i_t*)(lds + PG8_SB(b, h) + boff + n * 2048 + 1024)); } \
        else { _Pragma("unroll") for (int n = 0; n < 2; ++n) _Pragma("unroll") for (int k = 0; k < 2; ++k) dst[n][k] = *(const PG8_LAS bf16x8*)(lds + PG8_SB(b, h) + boff + n * 2048 + k * 1024); } } while (0)
#define PG8_CAT(x0, x1) __builtin_shufflevector((x0), (x1), 0, 1, 2, 3, 4, 5, 6, 7)
#define PG8_MMA(ai, bj, At, Bt) do { __builtin_amdgcn_s_setprio(1); _Pragma("unroll") for (int m = 0; m < 4; ++m) _Pragma("unroll") for (int n = 0; n < 2; ++n) { \
        if constexpr (FP8) acc[ai][bj][m][n] = __builtin_amdgcn_mfma_scale_f32_16x16x128_f8f6f4(Bt##8[n], At##8[m], acc[ai][bj][m][n], 0, 0, 0, 0x77777777, 0, 0x7f7f7f7f); \
        else { _Pragma("unroll") for (int k = 0; k < 2; ++k) acc[ai][bj][m][n] = __builtin_amdgcn_mfma_f32_16x16x32_bf16(Bt[n][k], At[m][k], acc[ai][bj][m][n], 0, 0, 0); } } __builtin_amdgcn_s_setprio(0); } while (0)
#define PG8_WAIT_V(n) asm volatile("s_waitcnt vmcnt(" #n ")" ::: "memory")
#define PG8_WAIT_L(n) asm volatile("s_waitcnt lgkmcnt(" #n ")" ::: "memory")
#define PG8_BAR __builtin_amdgcn_s_barrier()
#define PG8_SCHED __builtin_amdgcn_sched_barrier(0)
    Unit cur, nxt; int ui = 0;
    if (!S.next(0, cur)) return;
    f32x4 acc[2][2][4][2];
#pragma unroll
    for (int a = 0; a < 2; ++a)
#pragma unroll
        for (int b = 0; b < 2; ++b)
#pragma unroll
            for (int m = 0; m < 4; ++m)
#pragma unroll
                for (int n = 0; n < 2; ++n) acc[a][b][m][n] = (f32x4){0.f, 0.f, 0.f, 0.f};
    bf16x8 At[4][2], B0[2][2], B1[2][2];
    v8i_t At8[4], B08[2], B18[2];
    const char* cA = (const char*)g.A + (size_t)cur.pm * tstep; const char* cB = (const char*)g.Bt + (size_t)cur.pn * tstep;
    S.a_ready(cur);
    if constexpr (SP2) {
        PG8_STAGE(PG8_SB(0, 0), cB, voffB); PG8_STAGE(PG8_SB(0, 1), cB + hstep, voffB); PG8_STAGE(PG8_SA(0, 0), cA, voffA); PG8_STAGE(PG8_SA(0, 1), cA + hstep, voffA);
        if (wr == 1) PG8_BAR;
        PG8_WAIT_V(2); PG8_BAR;
        PG8_STAGE(PG8_SB(1, 0), cB + kstep, voffB); PG8_STAGE(PG8_SA(1, 0), cA + kstep, voffA); PG8_STAGE(PG8_SB(1, 1), cB + hstep + kstep, voffB);
        PG8_WAIT_V(6); PG8_BAR;
    } else {
        PG8_STAGE(PG8_SB(0, 0), cB, voffB); PG8_STAGE(PG8_SA(0, 0), cA, voffA); PG8_STAGE(PG8_SB(0, 1), cB + hstep, voffB); PG8_STAGE(PG8_SA(0, 1), cA + hstep, voffA);
        if (wr == 1) PG8_BAR;
        PG8_WAIT_V(4); PG8_BAR;
        PG8_STAGE(PG8_SB(1, 0), cB + kstep, voffB); PG8_STAGE(PG8_SA(1, 0), cA + kstep, voffA); PG8_STAGE(PG8_SB(1, 1), cB + hstep + kstep, voffB);
        PG8_WAIT_V(6); PG8_BAR;
    }
    for (;;) {
        const bool has_next = S.next(ui + 1, nxt);
        const char* nA = has_next ? (const char*)g.A + (size_t)nxt.pm * tstep : cA; const char* nB = has_next ? (const char*)g.Bt + (size_t)nxt.pn * tstep : cB;
_Pragma("unroll 1")
        for (int t = 0; t < nt; t += 2) {
            const bool last = (t == nt - 2);
            const char* a1 = cA + (size_t)(t + 1) * kstep;
            const char* a2 = last ? nA : cA + (size_t)(t + 2) * kstep; const char* b2 = last ? nB : cB + (size_t)(t + 2) * kstep;
            const char* a3 = a2 + kstep; const char* b3 = b2 + kstep;
            if (last && has_next) S.a_ready(nxt);
            if constexpr (SP2) {
            PG8_LDB(B0, 0, 0); PG8_LDB(B1, 0, 1); PG8_SCHED; PG8_LDA(At, 0, 0); PG8_STAGE(PG8_SA(1, 1), a1 + hstep, voffA);
            PG8_WAIT_V(8); PG8_WAIT_L(0); PG8_BAR; PG8_MMA(0, 0, At, B0); PG8_MMA(0, 1, At, B1); PG8_BAR; PG8_SCHED;
            PG8_LDA(At, 0, 1); PG8_STAGE(PG8_SB(0, 0), b2, voffB); PG8_STAGE(PG8_SB(0, 1), b2 + hstep, voffB); PG8_STAGE(PG8_SA(0, 0), a2, voffA);
            PG8_WAIT_V(8); PG8_WAIT_L(0); PG8_BAR; PG8_MMA(1, 0, At, B0); PG8_MMA(1, 1, At, B1); PG8_BAR; PG8_SCHED;
            PG8_LDB(B0, 1, 0); PG8_LDB(B1, 1, 1); PG8_SCHED; PG8_LDA(At, 1, 0); PG8_STAGE(PG8_SA(0, 1), a2 + hstep, voffA);
            PG8_WAIT_V(8); PG8_WAIT_L(0); PG8_BAR; PG8_MMA(0, 0, At, B0); PG8_MMA(0, 1, At, B1); PG8_BAR; PG8_SCHED;
            PG8_LDA(At, 1, 1); PG8_STAGE(PG8_SB(1, 0), b3, voffB); PG8_STAGE(PG8_SB(1, 1), b3 + hstep, voffB); PG8_STAGE(PG8_SA(1, 0), a3, voffA);
            PG8_WAIT_V(8); PG8_WAIT_L(0); PG8_BAR; PG8_MMA(1, 0, At, B0); PG8_MMA(1, 1, At, B1); PG8_BAR; PG8_SCHED;
            } else {
            PG8_LDB(B0, 0, 0); PG8_SCHED; PG8_LDA(At, 0, 0); PG8_STAGE(PG8_SA(1, 1), a1 + hstep, voffA);
            PG8_WAIT_L(8); PG8_BAR; PG8_WAIT_L(0); PG8_MMA(0, 0, At, B0); PG8_BAR; PG8_SCHED;
            PG8_LDB(B1, 0, 1); PG8_STAGE(PG8_SB(0, 0), b2, voffB);
            PG8_BAR; PG8_WAIT_L(0); PG8_MMA(0, 1, At, B1); PG8_BAR;
            PG8_LDA(At, 0, 1); PG8_STAGE(PG8_SA(0, 0), a2, voffA);
            PG8_BAR; PG8_WAIT_L(0); PG8_MMA(1, 0, At, B0); PG8_BAR; PG8_SCHED;
            PG8_STAGE(PG8_SB(0, 1), b2 + hstep, voffB);
            PG8_WAIT_V(6); PG8_BAR; PG8_MMA(1, 1, At, B1); PG8_BAR;
            PG8_LDB(B0, 1, 0); PG8_SCHED; PG8_LDA(At, 1, 0); PG8_STAGE(PG8_SA(0, 1), a2 + hstep, voffA);
            PG8_WAIT_L(8); PG8_BAR; PG8_WAIT_L(0); PG8_MMA(0, 0, At, B0); PG8_BAR; PG8_SCHED;
            PG8_LDB(B1, 1, 1); PG8_STAGE(PG8_SB(1, 0), b3, voffB);
            PG8_BAR; PG8_WAIT_L(0); PG8_MMA(0, 1, At, B1); PG8_BAR;
            PG8_LDA(At, 1, 1); PG8_STAGE(PG8_SA(1, 0), a3, voffA);
            PG8_BAR; PG8_WAIT_L(0); PG8_MMA(1, 0, At, B0); PG8_BAR; PG8_SCHED;
            PG8_STAGE(PG8_SB(1, 1), b3 + hstep, voffB);
            PG8_WAIT_V(6); PG8_BAR; PG8_MMA(1, 1, At, B1); PG8_BAR;
            }
        }
        if constexpr (ALIGN_EPI) { if (wr == 0) PG8_BAR; }
        if constexpr (!Epi::AFTER_DRAIN) { E(acc, cur, wr, wc, fr, fq); S.done(cur); }
        if (!has_next) break;
#pragma unroll
        for (int a = 0; a < 2; ++a)
#pragma unroll
            for (int b = 0; b < 2; ++b)
#pragma unroll
                for (int m = 0; m < 4; ++m)
#pragma unroll
                    for (int n = 0; n < 2; ++n) acc[a][b][m][n] = (f32x4){0.f, 0.f, 0.f, 0.f};
        cur = nxt; cA = nA; cB = nB; ++ui;
        if constexpr (ALIGN_EPI) { if (wr == 1) PG8_BAR; }
    }
    PG8_WAIT_V(0);
    if constexpr (!ALIGN_EPI) { if (wr == 0) PG8_BAR; }
    PG8_BAR;
    if constexpr (Epi::AFTER_DRAIN) { E.fused(acc, cur, wr, wc, fr, fq, lds, wid, lane); S.done(cur); }
#undef PG8_SA
#undef PG8_SB
#undef PG8_STAGE
#undef PG8_LDA
#undef PG8_LDB
#undef PG8_MMA
#undef PG8_CAT
#undef PG8_WAIT_V
#undef PG8_WAIT_L
#undef PG8_BAR
#undef PG8_SCHED
}
}

#ifndef P1_FP8
#define P1_FP8 1
#endif
#ifndef P1_FP8_UPTO
#define P1_FP8_UPTO 7680
#endif
#ifndef GDN_CMP
#define GDN_CMP 0
#define GDN_CMP_T0 0
#define GDN_CMP_T1 64
#define GDN_CMP_THR 0.01f
#endif
#ifndef GDN_NCHUNK
#define GDN_NCHUNK 32
#endif
#ifndef GDN_CHK
#define GDN_CHK 0
#endif
#ifndef GDN_TDBG
#define GDN_TDBG 0
#endif
#ifndef GDN_V1
#define GDN_V1 0
#endif
#ifndef TBL_P2_ROWS
#define TBL_P2_ROWS 20480
#endif
#ifndef MK_PROBE
#define MK_PROBE -1
#endif
#ifndef MK_ONE_LAUNCH
#define MK_ONE_LAUNCH 1
#endif
constexpr int NWAVES = 8, NTHREADS = 512, N_PHASES = 8;

constexpr int BATCH = 16, SEQ = 2048, DM = 1024, M = BATCH * SEQ;
constexpr int NIN = 7936;
constexpr float EPS = 1e-6f;
constexpr int NEXP = 16384;

constexpr size_t MiB = 1u << 20;
constexpr size_t WS_CTL = 0, CTL_ZERO_BYTES = 64 * 1024;
constexpr size_t WS_WIN = 1 * MiB;
constexpr size_t WS_WPA = 17 * MiB;
constexpr size_t WS_WPB = 18 * MiB;
constexpr size_t WS_WOUT = 20 * MiB;
constexpr size_t WS_WQ = 22 * MiB;
constexpr size_t WS_KEYS = 26 * MiB;
constexpr size_t WS_AB = 27 * MiB;
constexpr size_t WS_SSQ = 29 * MiB;
constexpr size_t WS_QA = 32 * MiB, WS_KA = 64 * MiB, WS_VA = 96 * MiB;
constexpr size_t WS_QB = 128 * MiB, WS_KB = 192 * MiB, WS_VB = 256 * MiB;
constexpr size_t WS_MERGE = 320 * MiB;
constexpr size_t WS_OB = 448 * MiB;
constexpr size_t WS_H8 = WS_OB;
constexpr size_t WS_W8 = WS_OB + 32 * MiB;
constexpr size_t WS_END = 512 * MiB;
constexpr size_t WS_MIXED = WS_KA;
constexpr size_t WS_X2B = WS_QB;
constexpr size_t WS_QP = WS_KB;
constexpr size_t WS_DOWN = WS_MERGE + 64 * MiB;
constexpr size_t WS_UP = WS_MERGE + 80 * MiB;
constexpr size_t WS_DSC = WS_MERGE + 96 * MiB;
constexpr size_t WS_USC = WS_DSC + 65536;
constexpr size_t WS_X2Q = WS_KA;
constexpr size_t WS_XSC = WS_KA + 32 * MiB;

constexpr int LDS_BYTES = 154880 + 64;

#define GAS __attribute__((address_space(1)))
#define LAS __attribute__((address_space(3)))
#define DI __device__ __forceinline__
typedef unsigned short bf16;
typedef float f32x4 __attribute__((ext_vector_type(4)));
typedef float f32x16 __attribute__((ext_vector_type(16)));
typedef short bf16x8 __attribute__((ext_vector_type(8)));
typedef unsigned u32x4 __attribute__((ext_vector_type(4)));
typedef unsigned u32x2 __attribute__((ext_vector_type(2)));
typedef float f32x2v __attribute__((ext_vector_type(2)));

DI unsigned f2bf(float f) { unsigned u = __builtin_bit_cast(unsigned, f); return (u + 0x7fffu + ((u >> 16) & 1u)) >> 16; }
DI unsigned pk2(float lo, float hi) { return f2bf(lo) | (f2bf(hi) << 16); }
DI float bflo(unsigned u) { return __builtin_bit_cast(float, u << 16); }
DI float bfhi(unsigned u) { return __builtin_bit_cast(float, u & 0xffff0000u); }
DI float wave_sum(float v) {
#pragma unroll
    for (int o = 1; o < 64; o <<= 1) v += __shfl_xor(v, o);
    return v;
}
DI float sigmoidf_(float x) { return 1.0f / (1.0f + __expf(-x)); }
DI float softplusf_(float x) { return fmaxf(x, 0.f) + log1pf(__expf(-fabsf(x))); }
DI int crow(int reg, int h) { return (reg & 3) + 8 * (reg >> 2) + 4 * h; }
DI void unpack8(const u32x4 r, float (&f)[8]) {
    f[0] = bflo(r.x); f[1] = bfhi(r.x); f[2] = bflo(r.y); f[3] = bfhi(r.y); f[4] = bflo(r.z); f[5] = bfhi(r.z); f[6] = bflo(r.w); f[7] = bfhi(r.w);
}
DI u32x4 pack8(const float (&f)[8]) { u32x4 r; r.x = pk2(f[0], f[1]); r.y = pk2(f[2], f[3]); r.z = pk2(f[4], f[5]); r.w = pk2(f[6], f[7]); return r; }
#define MFMA32(a, b, c) __builtin_amdgcn_mfma_f32_32x32x16_bf16((a), (b), (c), 0, 0, 0)
DI u32x4 bload16(__amdgpu_buffer_rsrc_t rs, unsigned voff) { return __builtin_bit_cast(u32x4, __builtin_amdgcn_raw_buffer_load_b128(rs, (int)voff, 0, 0)); }
DI u32x4 bload16s(__amdgpu_buffer_rsrc_t rs, unsigned voff, unsigned soff) { return __builtin_bit_cast(u32x4, __builtin_amdgcn_raw_buffer_load_b128(rs, (int)voff, (int)soff, 0)); }
typedef short v4i16_t __attribute__((ext_vector_type(4)));
typedef __bf16 bf16x2_t __attribute__((ext_vector_type(2)));
DI unsigned pkbf(float lo, float hi) { typedef float f32x2_t __attribute__((ext_vector_type(2))); f32x2_t v = {lo, hi}; return __builtin_bit_cast(unsigned, __builtin_convertvector(v, bf16x2_t)); }

struct Args { const float* in[20]; float* out; unsigned char* ws; int ph_lo, ph_hi, probe, dry; };

namespace pg8 {
struct EpiIn {
    static constexpr bool PERM = true, AFTER_DRAIN = false;
    unsigned char* ws; bf16_t* GATE; const float *b_merge, *a_log, *dt_bias; int pn_off;
    __device__ __forceinline__ void operator()(const f32x4 (&acc)[2][2][4][2], const Unit& u, int wr, int wc, int fr, int fq) const {
        const int pn = u.pn + pn_off, row0 = u.pm * BM + wr * 64 + fr, cloc = wc * 32 + 8 * fq;
        {
            bf16_t* base; int ldc, colt, mode;
            if (pn < 6) { const int t = pn >> 1; base = (bf16_t*)(ws + WS_QA + (size_t)t * (WS_KA - WS_QA)); ldc = 512; colt = (pn & 1) * 256; mode = 0; }
            else if (pn < 18) { const int t = (pn - 6) >> 2; base = (bf16_t*)(ws + WS_QB + (size_t)t * (WS_KB - WS_QB)); ldc = 1024; colt = ((pn - 6) & 3) * 256; mode = 0; }
            else if (pn < 22) { base = GATE; ldc = 1024; colt = (pn - 18) * 256; mode = 1; }
            else { base = (bf16_t*)(ws + WS_MERGE); ldc = 2048; colt = (pn - 22) * 256; mode = 2; }
#pragma unroll
            for (int bj = 0; bj < 2; ++bj) {
                f32x4 b0 = (f32x4){0.f, 0.f, 0.f, 0.f}, b1 = b0;
                if (mode == 2) { b0 = *(const f32x4*)(b_merge + colt + bj * HALF + cloc); b1 = *(const f32x4*)(b_merge + colt + bj * HALF + cloc + 4); }
#pragma unroll
                for (int ai = 0; ai < 2; ++ai)
#pragma unroll
                    for (int m = 0; m < 4; ++m) {
                        f32x4 v0 = acc[ai][bj][m][0], v1 = acc[ai][bj][m][1];
                        if (mode == 1) {
#pragma unroll
                            for (int e = 0; e < 4; ++e) { v0[e] = v0[e] * __builtin_amdgcn_rcpf(1.0f + __builtin_amdgcn_exp2f(-1.4426950408889634f * v0[e])); v1[e] = v1[e] * __builtin_amdgcn_rcpf(1.0f + __builtin_amdgcn_exp2f(-1.4426950408889634f * v1[e])); }
                        } else if (mode == 2) {
#pragma unroll
                            for (int e = 0; e < 4; ++e) { v0[e] = __builtin_amdgcn_rcpf(1.0f + __builtin_amdgcn_exp2f(-1.4426950408889634f * (v0[e] + b0[e]))); v1[e] = __builtin_amdgcn_rcpf(1.0f + __builtin_amdgcn_exp2f(-1.4426950408889634f * (v1[e] + b1[e]))); }
                        }
                        if (mode == 2) {
                            unsigned g0 = 0u, g1 = 0u;
                            g0 = __builtin_amdgcn_cvt_pk_u8_f32(v0[0] * 255.0f + 0.5f, 0, g0); g0 = __builtin_amdgcn_cvt_pk_u8_f32(v0[1] * 255.0f + 0.5f, 1, g0); g0 = __builtin_amdgcn_cvt_pk_u8_f32(v0[2] * 255.0f + 0.5f, 2, g0); g0 = __builtin_amdgcn_cvt_pk_u8_f32(v0[3] * 255.0f + 0.5f, 3, g0);
                            g1 = __builtin_amdgcn_cvt_pk_u8_f32(v1[0] * 255.0f + 0.5f, 0, g1); g1 = __builtin_amdgcn_cvt_pk_u8_f32(v1[1] * 255.0f + 0.5f, 1, g1); g1 = __builtin_amdgcn_cvt_pk_u8_f32(v1[2] * 255.0f + 0.5f, 2, g1); g1 = __builtin_amdgcn_cvt_pk_u8_f32(v1[3] * 255.0f + 0.5f, 3, g1);
                            *(u32x2*)((unsigned char*)base + (size_t)(row0 + ai * HALF + m * 16) * 2048 + colt + bj * HALF + cloc) = (u32x2){g0, g1};
                        } else {
                        u32x4 w; w.x = cvt_pk_bf16(v0[0], v0[1]); w.y = cvt_pk_bf16(v0[2], v0[3]); w.z = cvt_pk_bf16(v1[0], v1[1]); w.w = cvt_pk_bf16(v1[2], v1[3]);
                        *(u32x4*)(base + (size_t)(row0 + ai * HALF + m * 16) * ldc + colt + bj * HALF + cloc) = w; }
                    }
            }
        }
    }
};
template <bool SECOND> struct EpiMix {
    static constexpr bool PERM = true, AFTER_DRAIN = false;
    bf16_t* MIXED; const unsigned char* GATES; const bf16_t* PART;
    __device__ __forceinline__ void operator()(const f32x4 (&acc)[2][2][4][2], const Unit& u, int wr, int wc, int fr, int fq) const {
        const int row0 = u.pm * BM + wr * 64 + fr, col0 = u.pn * BM + wc * 32 + 8 * fq;
#pragma unroll
        for (int ai = 0; ai < 2; ++ai)
#pragma unroll
            for (int m = 0; m < 4; ++m)
#pragma unroll
                for (int bj = 0; bj < 2; ++bj) {
                    const size_t row = (size_t)(row0 + ai * HALF + m * 16); const int col = col0 + bj * HALF;
                    const u32x2 g = *(const u32x2*)(GATES + row * 2048 + col);
                    float gv[8];
#pragma unroll
                    for (int e = 0; e < 4; ++e) { gv[e] = (float)((g.x >> (8 * e)) & 255u) * (1.0f / 255.0f); gv[4 + e] = (float)((g.y >> (8 * e)) & 255u) * (1.0f / 255.0f); }
                    const f32x4 a0 = acc[ai][bj][m][0], a1 = acc[ai][bj][m][1];
                    float o[8];
#pragma unroll
                    for (int e = 0; e < 4; ++e) { o[e] = a0[e] * gv[e]; o[4 + e] = a1[e] * gv[4 + e]; }
                    bf16_t* dst = MIXED + row * 1024 + col;
                    if (SECOND) { const u32x4 p = *(const u32x4*)(PART + row * 1024 + col);
                        o[0] += __builtin_bit_cast(float, p.x << 16); o[1] += __builtin_bit_cast(float, p.x & 0xffff0000u); o[2] += __builtin_bit_cast(float, p.y << 16); o[3] += __builtin_bit_cast(float, p.y & 0xffff0000u);
                        o[4] += __builtin_bit_cast(float, p.z << 16); o[5] += __builtin_bit_cast(float, p.z & 0xffff0000u); o[6] += __builtin_bit_cast(float, p.w << 16); o[7] += __builtin_bit_cast(float, p.w & 0xffff0000u); }
                    u32x4 w; w.x = cvt_pk_bf16(o[0], o[1]); w.y = cvt_pk_bf16(o[2], o[3]); w.z = cvt_pk_bf16(o[4], o[5]); w.w = cvt_pk_bf16(o[6], o[7]);
                    *(u32x4*)dst = w;
                }
    }
};
struct EpiOut {
    static constexpr bool PERM = false, AFTER_DRAIN = false;
    const float* X; float* OUT; bf16_t* X2B; float* SSQ;
    __device__ __forceinline__ void operator()(const f32x4 (&acc)[2][2][4][2], const Unit& u, int wr, int wc, int fr, int fq) const {
        const int row0 = u.pm * BM + wr * 64 + fr, col0 = u.pn * BM + wc * 32 + 4 * fq;
#pragma unroll
        for (int ai = 0; ai < 2; ++ai)
#pragma unroll
            for (int m = 0; m < 4; ++m) {
                const size_t row = (size_t)(row0 + ai * HALF + m * 16); float ss = 0.f;
#pragma unroll
                for (int bj = 0; bj < 2; ++bj)
#pragma unroll
                    for (int n = 0; n < 2; ++n) {
                        const size_t off = row * 1024 + col0 + bj * HALF + n * 16;
                        const f32x4 o = *(const f32x4*)(X + off) + acc[ai][bj][m][n];
                        ss += (o[0] * o[0] + o[1] * o[1]) + (o[2] * o[2] + o[3] * o[3]);
                        unsigned lo = cvt_pk_bf16(o[0], o[1]), hi = cvt_pk_bf16(o[2], o[3]);
                        *(unsigned long long*)(X2B + off) = (unsigned long long)lo | ((unsigned long long)hi << 32);
                    }
                ss += __shfl_xor(ss, 16); ss += __shfl_xor(ss, 32);
                if (fq == 0) SSQ[row * 16 + u.pn * 4 + wc] = ss;
            }
    }
};
struct RowTileOrder {
    int pm, nN;
    __device__ __forceinline__ bool next(int i, Unit& u) const { if (i >= nN) return false; u.pm = pm; u.pn = i; return true; }
    __device__ __forceinline__ void a_ready(const Unit&) const {}
    __device__ __forceinline__ void done(const Unit&) const {}
};
struct EpiPlain {
    static constexpr bool PERM = true, AFTER_DRAIN = false;
    bf16_t* O; int ldc;
    __device__ __forceinline__ void operator()(const f32x4 (&acc)[2][2][4][2], const Unit& u, int wr, int wc, int fr, int fq) const {
        const int row0 = u.pm * BM + wr * 64 + fr, col0 = u.pn * BM + wc * 32 + 8 * fq;
#pragma unroll
        for (int ai = 0; ai < 2; ++ai)
#pragma unroll
            for (int m = 0; m < 4; ++m)
#pragma unroll
                for (int bj = 0; bj < 2; ++bj) {
                    const f32x4 v0 = acc[ai][bj][m][0], v1 = acc[ai][bj][m][1];
                    u32x4 w; w.x = cvt_pk_bf16(v0[0], v0[1]); w.y = cvt_pk_bf16(v0[2], v0[3]); w.z = cvt_pk_bf16(v1[0], v1[1]); w.w = cvt_pk_bf16(v1[2], v1[3]);
                    *(u32x4*)(O + (size_t)(row0 + ai * HALF + m * 16) * ldc + col0 + bj * HALF) = w;
                }
    }
};
}

template <int MODE> DI void p0_transpose_item(const float* W, int ldw, bf16* WT, int ldk, int nblk, const float* sc, LAS float* scr, int item, int lane) {
    const int kb = item / nblk, nb = item % nblk, k0 = 64 * kb, n0 = 32 * nb;
    const int nn = n0 + (lane & 31); int src = nn; bool valid = true;
    if (MODE == 1) { if (nn < 4608) src = nn; else if (nn < 7680) src = nn + 16; else if (nn < 7696) src = nn - 7680 + 4608; else { valid = false; src = 0; } }
#pragma unroll 8
    for (int i = 0; i < 32; ++i) { const int kk = 2 * i + (lane >> 5); float v = W[(size_t)(k0 + kk) * ldw + src]; if (!valid) v = 0.f; if (MODE == 2) v *= sc[k0 + kk]; scr[kk * 33 + (lane & 31)] = v; }
    asm volatile("s_waitcnt lgkmcnt(0)" ::: "memory");
    const int c = lane & 7;
#pragma unroll
    for (int j = 0; j < 4; ++j) { const int n = (lane >> 3) + 8 * j; const LAS float* s = scr + (8 * c) * 33 + n;
        u32x4 o; o.x = pk2(s[0 * 33], s[1 * 33]); o.y = pk2(s[2 * 33], s[3 * 33]); o.z = pk2(s[4 * 33], s[5 * 33]); o.w = pk2(s[6 * 33], s[7 * 33]);
        *(u32x4*)(WT + (size_t)(n0 + n) * ldk + k0 + 8 * c) = o; }
    asm volatile("s_waitcnt lgkmcnt(0)" ::: "memory");
}
DI void p0_transpose_item_fp8(const float* W, int ldw, unsigned char* WT8, int ldk, int nblk, LAS float* scr, int item, int lane) {
    const int kb = item / nblk, nb = item % nblk, k0 = 64 * kb, n0 = 32 * nb;
    const int nn = n0 + (lane & 31); int src = nn; bool valid = true;
    { if (nn < 4608) src = nn; else if (nn < 7680) src = nn + 16; else if (nn < 7696) src = nn - 7680 + 4608; else { valid = false; src = 0; } }
#pragma unroll 8
    for (int i = 0; i < 32; ++i) { const int kk = 2 * i + (lane >> 5); float v = W[(size_t)(k0 + kk) * ldw + src]; if (!valid) v = 0.f; scr[kk * 33 + (lane & 31)] = v * 256.0f; }
    asm volatile("s_waitcnt lgkmcnt(0)" ::: "memory");
    const int c = lane & 7;
#pragma unroll
    for (int j = 0; j < 4; ++j) { const int n = (lane >> 3) + 8 * j; const LAS float* s = scr + (8 * c) * 33 + n;
        int w0 = __builtin_amdgcn_cvt_pk_fp8_f32(s[0 * 33], s[1 * 33], 0, false); w0 = __builtin_amdgcn_cvt_pk_fp8_f32(s[2 * 33], s[3 * 33], w0, true);
        int w1 = __builtin_amdgcn_cvt_pk_fp8_f32(s[4 * 33], s[5 * 33], 0, false); w1 = __builtin_amdgcn_cvt_pk_fp8_f32(s[6 * 33], s[7 * 33], w1, true);
        *(u32x2*)(WT8 + (size_t)(n0 + n) * ldk + k0 + 8 * c) = (u32x2){(unsigned)w0, (unsigned)w1}; }
    asm volatile("s_waitcnt lgkmcnt(0)" ::: "memory");
}
DI void rms_row_to_bf16(const float* xrow, const float* w, bf16* orow, int lane) {
    const f32x4* xr = (const f32x4*)xrow + lane; const f32x4* wr = (const f32x4*)w + lane;
    f32x4 v[4]; float s = 0.f;
#pragma unroll
    for (int j = 0; j < 4; ++j) { v[j] = xr[64 * j]; s += (v[j].x * v[j].x + v[j].y * v[j].y) + (v[j].z * v[j].z + v[j].w * v[j].w); }
    const float rstd = 1.0f / sqrtf(wave_sum(s) * (1.0f / DM) + EPS);
    unsigned long long* o8 = (unsigned long long*)orow + lane;
#pragma unroll
    for (int j = 0; j < 4; ++j) { const f32x4 ww = wr[64 * j]; const f32x4 o = v[j] * rstd * ww; o8[64 * j] = (unsigned long long)pk2(o.x, o.y) | ((unsigned long long)pk2(o.z, o.w) << 32); }
}

DI void wk_tile(const Args& a, int job, int lane) {
    const int r32 = lane & 31, hi = lane >> 5;
    const int blk = job >> 7, h = blk >> 1, p = blk & 1, kt = (job & 127) >> 5, jt = job & 31;
    const float* kp = (p == 0 ? a.in[16] : a.in[17]) + ((size_t)(h * 128 + kt * 32 + r32)) * 128 + 8 * hi;
    const int j = jt * 32 + r32; const float* wp = a.in[15] + (size_t)j * 2048 + h * 256 + p * 128 + 8 * hi; const float wn = a.in[14][j];
    f32x16 acc;
#pragma unroll
    for (int r = 0; r < 16; ++r) acc[r] = 0.f;
#pragma unroll
    for (int s = 0; s < 8; ++s) {
        const f32x4 k0 = *(const f32x4*)(kp + 16 * s), k1 = *(const f32x4*)(kp + 16 * s + 4), w0 = *(const f32x4*)(wp + 16 * s) * wn, w1 = *(const f32x4*)(wp + 16 * s + 4) * wn;
        u32x4 ka, wb; ka.x = pkbf(k0.x, k0.y); ka.y = pkbf(k0.z, k0.w); ka.z = pkbf(k1.x, k1.y); ka.w = pkbf(k1.z, k1.w); wb.x = pkbf(w0.x, w0.y); wb.y = pkbf(w0.z, w0.w); wb.z = pkbf(w1.x, w1.y); wb.w = pkbf(w1.z, w1.w);
        acc = MFMA32(__builtin_bit_cast(bf16x8, ka), __builtin_bit_cast(bf16x8, wb), acc); }
    bf16* dst = (bf16*)(a.ws + WS_WQ) + ((size_t)(blk * 128 + kt * 32)) * 1024 + j;
#pragma unroll
    for (int r = 0; r < 16; ++r) dst[(size_t)crow(r, hi) * 1024] = (bf16)(pkbf(acc[r], 0.f) & 0xffffu);
}
DI void phase0(const Args& a, LAS unsigned char* lds, int gw, int NGW, int wave, int lane) {
    unsigned char* ws = a.ws;
    LAS float* scr = (LAS float*)(lds + wave * 16384);
    constexpr int I_IN = 16 * (NIN / 32), I_PA = 8 * 32, I_PB = 16 * 32, I_OUT = 16 * 32, I_Q = 16 * 4 * 32;
    constexpr int NITEMS = I_IN + I_PA + I_PB + I_OUT + I_Q;
    for (int it = gw; it < NITEMS; it += NGW) {
        int r = it;
#if P1_FP8
        if (r < I_IN) { const int nb_ = r % (NIN / 32); if (nb_ >= P1_FP8_UPTO / 32) p0_transpose_item<1>(a.in[2], 7696, (bf16*)(ws + WS_WIN), 1024, NIN / 32, nullptr, scr, r, lane);
                        else p0_transpose_item_fp8(a.in[2], 7696, ws + WS_W8, 1024, NIN / 32, scr, r, lane); continue; } r -= I_IN;
#else
        if (r < I_IN) { p0_transpose_item<1>(a.in[2], 7696, (bf16*)(ws + WS_WIN), 1024, NIN / 32, nullptr, scr, r, lane); continue; } r -= I_IN;
#endif
        if (r < I_PA) { p0_transpose_item<0>(a.in[11], 1024, (bf16*)(ws + WS_WPA), 512, 32, nullptr, scr, r, lane); continue; } r -= I_PA;
        if (r < I_PB) { p0_transpose_item<0>(a.in[12], 1024, (bf16*)(ws + WS_WPB), 1024, 32, nullptr, scr, r, lane); continue; } r -= I_PB;
        if (r < I_OUT) { p0_transpose_item<0>(a.in[13], 1024, (bf16*)(ws + WS_WOUT), 1024, 32, nullptr, scr, r, lane); continue; } r -= I_OUT;
        wk_tile(a, r, lane);
    }
    { f32x4 wv[4];
#pragma unroll
      for (int j = 0; j < 4; ++j) wv[j] = ((const f32x4*)a.in[1])[lane + 64 * j];
      for (int m0 = gw * 4; m0 < M; m0 += NGW * 4) {
        f32x4 v[4][4];
#pragma unroll
        for (int q = 0; q < 4; ++q) { const f32x4* xr = (const f32x4*)(a.in[0] + (size_t)(m0 + q) * DM) + lane;
#pragma unroll
            for (int j = 0; j < 4; ++j) v[q][j] = xr[64 * j]; }
#pragma unroll
        for (int q = 0; q < 4; ++q) { float ssq = 0.f;
#pragma unroll
            for (int j = 0; j < 4; ++j) ssq += (v[q][j].x * v[q][j].x + v[q][j].y * v[q][j].y) + (v[q][j].z * v[q][j].z + v[q][j].w * v[q][j].w);
            const float rstd = 1.0f / sqrtf(wave_sum(ssq) * (1.0f / DM) + EPS);
            unsigned long long* o8 = (unsigned long long*)((bf16*)a.out + (size_t)(m0 + q) * DM) + lane;
#pragma unroll
            for (int j = 0; j < 4; ++j) { const f32x4 o = v[q][j] * rstd * wv[j]; o8[64 * j] = (unsigned long long)pkbf(o.x, o.y) | ((unsigned long long)pkbf(o.z, o.w) << 32);
#if P1_FP8
                int w8 = __builtin_amdgcn_cvt_pk_fp8_f32(o.x, o.y, 0, false); w8 = __builtin_amdgcn_cvt_pk_fp8_f32(o.z, o.w, w8, true); ((unsigned*)(ws + WS_H8 + (size_t)(m0 + q) * DM))[lane + 64 * j] = (unsigned)w8;
#endif
            } }
      } }
}


typedef float f32x4m __attribute__((ext_vector_type(4)));
DI void ab_rows(const Args& a, int bx, int wave, int lane) {
    const int fr = lane & 15, fq = lane >> 4, row0 = 128 * bx + 16 * wave;
    const bf16* Ap = (const bf16*)a.out + (size_t)(row0 + fr) * 1024 + 8 * fq;
    const bf16* Bp = (const bf16*)(a.ws + WS_WIN) + (size_t)(7680 + fr) * 1024 + 8 * fq;
    f32x4m acc = {0.f, 0.f, 0.f, 0.f};
#pragma unroll 8
    for (int s = 0; s < 32; ++s) { const bf16x8 af = *(const bf16x8*)(Ap + 32 * s), bfr = *(const bf16x8*)(Bp + 32 * s); acc = __builtin_amdgcn_mfma_f32_16x16x32_bf16(af, bfr, acc, 0, 0, 0); }
    const int hcol = fr & 7; const float al = a.in[7][hcol], db = a.in[8][hcol];
#pragma unroll
    for (int i = 0; i < 4; ++i) { float v = acc[i];
        if (fr < 8) { const float x = v + db; v = -__expf(al) * (fmaxf(x, 0.f) + log1pf(__expf(-fabsf(x)))); } else v = 1.0f / (1.0f + __expf(-v));
        ((float*)(a.ws + WS_AB))[(size_t)(row0 + 4 * fq + i) * 16 + fr] = v; }
}
DI bf16x8 pack_frag(const f32x16& x, int s) {
    u32x4 p; p.x = pg8::cvt_pk_bf16(x[8 * s + 0], x[8 * s + 1]); p.y = pg8::cvt_pk_bf16(x[8 * s + 2], x[8 * s + 3]); p.z = pg8::cvt_pk_bf16(x[8 * s + 4], x[8 * s + 5]); p.w = pg8::cvt_pk_bf16(x[8 * s + 6], x[8 * s + 7]);
    return __builtin_bit_cast(bf16x8, p);
}
DI float sumsq8(const u32x4 r) { float f[8]; unpack8(r, f); float s = 0.f;
#pragma unroll
    for (int j = 0; j < 8; ++j) s += f[j] * f[j];
    return s; }
DI void attn_unit(const Args& a, int b, int n, LAS unsigned char* wl, int head, int lane, bool dry) {
    const int r32 = lane & 31, hi = lane >> 5;
    LAS bf16* vt = (LAS bf16*)wl;
    LAS float* bias = (LAS float*)(wl + 9216);
    LAS u32x4* qfl = (LAS u32x4*)(wl + 9216 + 768);
    LAS float* rkl = (LAS float*)(wl + 9216 + 768 + 8192);
    unsigned char* ws = a.ws;
    bf16* QA = (bf16*)(ws + WS_QA); const bf16* KA = (const bf16*)(ws + WS_KA); const bf16* VA = (const bf16*)(ws + WS_VA);
    for (int i = lane; i < 192; i += 64) bias[i] = a.in[5][head * 257 + 65 + i];
    bf16* Qp = QA + ((size_t)(b * SEQ + n * 64)) * 512 + head * 64;
#pragma unroll
    for (int qh = 0; qh < 2; ++qh) {
        u32x4 raw[4]; float ss = 0.f;
#pragma unroll
        for (int s = 0; s < 4; ++s) { raw[s] = *(const u32x4*)(Qp + (size_t)(qh * 32 + r32) * 512 + 16 * s + 8 * hi); ss += sumsq8(raw[s]); }
        ss += __shfl_xor(ss, 32);
        const float rstd = 0.125f / sqrtf(ss * (1.0f / 64.0f) + EPS);
#pragma unroll
        for (int s = 0; s < 4; ++s) { float f[8]; unpack8(raw[s], f);
#pragma unroll
            for (int j = 0; j < 8; ++j) { const int d = 16 * s + 8 * hi + j; f[j] *= rstd * a.in[3][d] * a.in[4][d]; }
            qfl[(qh * 4 + s) * 64 + lane] = pack8(f); }
    }
    float mrun[2] = {-1e30f, -1e30f}, lrun[2] = {0.f, 0.f};
    f32x16 o[2][2];
#pragma unroll
    for (int d = 0; d < 2; ++d)
#pragma unroll
        for (int q = 0; q < 2; ++q)
#pragma unroll
            for (int r = 0; r < 16; ++r) o[d][q][r] = 0.f;
    const int jb0 = (n >= 8) ? 0 : 8 - n;
    u32x4 kraw[2][4], vraw[8];
    const __amdgpu_buffer_rsrc_t rsK = __builtin_amdgcn_make_buffer_rsrc((void*)(ws + WS_KA), (short)0, (int)(32 * MiB), 0x00020000), rsV = __builtin_amdgcn_make_buffer_rsrc((void*)(ws + WS_VA), (short)0, (int)(32 * MiB), 0x00020000);
    const unsigned kvo = (unsigned)(r32 * 512 + 8 * hi) * 2u, vvo = (unsigned)((lane >> 3) * 512 + (lane & 7) * 8) * 2u;
#define ATT_LOADK(jbx) do { const unsigned so_ = (unsigned)(((b * SEQ + (n + (jbx) - 8) * 64) * 512 + head * 64) * 2); \
        _Pragma("unroll") for (int kb = 0; kb < 2; ++kb) _Pragma("unroll") for (int s = 0; s < 4; ++s) kraw[kb][s] = bload16s(rsK, kvo, so_ + (unsigned)((kb * 32 * 512 + 16 * s) * 2)); } while (0)
#define ATT_LOADV(jbx) do { const unsigned so_ = (unsigned)(((b * SEQ + (n + (jbx) - 8) * 64) * 512 + head * 64) * 2); \
        _Pragma("unroll") for (int it = 0; it < 8; ++it) vraw[it] = bload16s(rsV, vvo, so_ + (unsigned)(it * 8 * 512 * 2)); } while (0)
    ATT_LOADK(jb0); ATT_LOADV(jb0);
    for (int jb = jb0; jb <= 8; ++jb) {
        asm volatile("s_waitcnt lgkmcnt(0)" ::: "memory");
#pragma unroll
        for (int it = 0; it < 8; ++it) *(LAS u32x4*)(vt + (it * 8 + (lane >> 3)) * 72 + (lane & 7) * 8) = vraw[it];
        if (jb < 8) ATT_LOADV(jb + 1);
        bf16x8 kf[2][4]; float rk[2];
#pragma unroll
        for (int kb = 0; kb < 2; ++kb) { float ss = 0.f;
#pragma unroll
            for (int s = 0; s < 4; ++s) { kf[kb][s] = __builtin_bit_cast(bf16x8, kraw[kb][s]); ss += sumsq8(kraw[kb][s]); }
            ss += __shfl_xor(ss, 32); rk[kb] = 1.0f / sqrtf(ss * (1.0f / 64.0f) + EPS); if (hi == 0) rkl[kb * 32 + r32] = rk[kb]; }
        f32x16 p[2][2];
#pragma unroll
        for (int kb = 0; kb < 2; ++kb)
#pragma unroll
            for (int qh = 0; qh < 2; ++qh) {
#pragma unroll
                for (int r = 0; r < 16; ++r) p[kb][qh][r] = 0.f;
#pragma unroll
                for (int s = 0; s < 4; ++s) p[kb][qh] = MFMA32(kf[kb][s], __builtin_bit_cast(bf16x8, qfl[(qh * 4 + s) * 64 + lane]), p[kb][qh]);
            }
        if (jb < 8) ATT_LOADK(jb + 1);
#pragma unroll
        for (int kb = 0; kb < 2; ++kb)
#pragma unroll
            for (int r = 0; r < 16; ++r) {
                const int kr = crow(r, hi); const float rs = (*(const LAS f32x4*)(rkl + kb * 32 + 8 * (r >> 2) + 4 * hi))[r & 3];
                const int j = jb * 64 + kb * 32 + kr;
#pragma unroll
                for (int qh = 0; qh < 2; ++qh) { int rel = 512 + qh * 32 + r32 - j; rel = rel < -128 ? -128 : (rel > 128 ? 128 : rel);
                    p[kb][qh][r] = p[kb][qh][r] * rs + bias[rel + 63]; }
            }
#pragma unroll
        for (int qh = 0; qh < 2; ++qh) {
            float mx = -1e30f;
#pragma unroll
            for (int kb = 0; kb < 2; ++kb)
#pragma unroll
                for (int r = 0; r < 16; ++r) mx = fmaxf(mx, p[kb][qh][r]);
            mx = fmaxf(mx, __shfl_xor(mx, 32));
            const float mnew = fmaxf(mrun[qh], mx), alpha = __expf(mrun[qh] - mnew);
            float sum = 0.f;
#pragma unroll
            for (int kb = 0; kb < 2; ++kb)
#pragma unroll
                for (int r = 0; r < 16; ++r) { const float e = __expf(p[kb][qh][r] - mnew); p[kb][qh][r] = e; sum += e; }
            sum += __shfl_xor(sum, 32);
            lrun[qh] = lrun[qh] * alpha + sum; mrun[qh] = mnew;
#pragma unroll
            for (int d = 0; d < 2; ++d)
#pragma unroll
                for (int r = 0; r < 16; ++r) o[d][qh][r] *= alpha;
        }
        asm volatile("s_waitcnt lgkmcnt(0)" ::: "memory");
#pragma unroll
        for (int kb = 0; kb < 2; ++kb)
#pragma unroll
            for (int s2 = 0; s2 < 2; ++s2) {
                bf16x8 af[2];
#pragma unroll
                for (int d = 0; d < 2; ++d) {
                    const LAS bf16* rp = vt + (kb * 32 + 16 * s2 + 4 * hi + ((lane & 15) >> 2)) * 72 + d * 32 + 16 * ((lane >> 4) & 1) + 4 * (lane & 3);
                    const v4i16_t lo = __builtin_amdgcn_ds_read_tr16_b64_v4i16((LAS v4i16_t*)rp), hi2 = __builtin_amdgcn_ds_read_tr16_b64_v4i16((LAS v4i16_t*)(rp + 8 * 72));
                    af[d] = (bf16x8){lo[0], lo[1], lo[2], lo[3], hi2[0], hi2[1], hi2[2], hi2[3]}; }
#pragma unroll
                for (int qh = 0; qh < 2; ++qh) { const bf16x8 bfq = pack_frag(p[kb][qh], s2);
#pragma unroll
                    for (int d = 0; d < 2; ++d) o[d][qh] = MFMA32(af[d], bfq, o[d][qh]); }
            }
    }
#undef ATT_LOADK
#undef ATT_LOADV
    if (!dry) {
#pragma unroll
    for (int qh = 0; qh < 2; ++qh) { const float inv = 1.0f / lrun[qh];
#pragma unroll
        for (int d = 0; d < 2; ++d)
#pragma unroll
            for (int r = 0; r < 16; ++r) Qp[(size_t)(qh * 32 + r32) * 512 + d * 32 + crow(r, hi)] = (bf16)(pkbf(o[d][qh][r] * inv, 0.f) & 0xffffu);
    }
    }
}

DI void gdn_seq(const Args& a, int bh, LAS unsigned char* lds, int tid) {
    const int b = bh >> 3, h = bh & 7;
    unsigned char* ws = a.ws;
    LAS float* qs = (LAS float*)lds; LAS float* ks = qs + 64 * 128; LAS float* vs = ks + 64 * 128; LAS float* os = vs + 64 * 128;
    LAS float* eg = os + 64 * 128; LAS float* be = eg + 64;
    const float* AB = (const float*)(ws + WS_AB);
    const bf16* GATE = (const bf16*)a.out + (size_t)M * DM;
    bf16* OB = (bf16*)(ws + WS_OB);
    const int tens = tid >> 7, rb = (tid & 127) >> 4, seg = tid & 15;
    float cw[4][8];
#pragma unroll
    for (int i = 0; i < 4; ++i)
#pragma unroll
        for (int j = 0; j < 8; ++j) cw[i][j] = (tid < 384) ? a.in[6][(size_t)i * 3072 + tens * 1024 + h * 128 + seg * 8 + j] : 0.f;
    const bf16* srcT = (const bf16*)(ws + WS_QB + (size_t)(tens > 2 ? 2 : tens) * (WS_KB - WS_QB));
    LAS float* dstT = qs + (tens > 2 ? 2 : tens) * (64 * 128);
    const int dv = tid >> 2, part = tid & 3;
    float S[32];
#pragma unroll
    for (int i = 0; i < 32; ++i) S[i] = 0.f;
    for (int n = 0; n < 32; ++n) {
        if (tid < 384) {
            float x[11][8];
#pragma unroll
            for (int i = 0; i < 11; ++i) { const int tpos = n * 64 + rb * 8 - 3 + i;
                if (tpos >= 0) { const u32x4 raw = *(const u32x4*)(srcT + ((size_t)(b * SEQ + tpos)) * 1024 + h * 128 + seg * 8); unpack8(raw, x[i]); }
                else {
#pragma unroll
                    for (int j = 0; j < 8; ++j) x[i][j] = 0.f; } }
#pragma unroll
            for (int r = 0; r < 8; ++r) { float y[8]; float ss = 0.f;
#pragma unroll
                for (int j = 0; j < 8; ++j) { float v = cw[0][j] * x[r][j] + cw[1][j] * x[r + 1][j] + cw[2][j] * x[r + 2][j] + cw[3][j] * x[r + 3][j]; v = v / (1.0f + __expf(-v)); y[j] = v; ss += v * v; }
                if (tens < 2) { ss += __shfl_xor(ss, 1); ss += __shfl_xor(ss, 2); ss += __shfl_xor(ss, 4); ss += __shfl_xor(ss, 8);
                    const float sc = (tens == 0 ? 0.08838834764831845f : 1.0f) / sqrtf(ss + EPS);
#pragma unroll
                    for (int j = 0; j < 8; ++j) y[j] *= sc; }
                LAS float* d = dstT + (rb * 8 + r) * 128 + seg * 8;
                *(LAS f32x4*)d = (f32x4){y[0], y[1], y[2], y[3]}; *(LAS f32x4*)(d + 4) = (f32x4){y[4], y[5], y[6], y[7]}; }
        } else if (tid < 448) { const int t = tid - 384; const size_t row = (size_t)(b * SEQ + n * 64 + t);
            eg[t] = __expf(AB[row * 16 + h]); be[t] = AB[row * 16 + 8 + h]; }
        __syncthreads();
        for (int t = 0; t < 64; ++t) {
            const LAS f32x4* kp = (const LAS f32x4*)(ks + t * 128 + part * 32); const LAS f32x4* qp = (const LAS f32x4*)(qs + t * 128 + part * 32);
            f32x4 kv[8]; float kS0 = 0.f, kS1 = 0.f;
#pragma unroll
            for (int i = 0; i < 8; ++i) { kv[i] = kp[i]; kS0 += kv[i].x * S[4 * i] + kv[i].y * S[4 * i + 1]; kS1 += kv[i].z * S[4 * i + 2] + kv[i].w * S[4 * i + 3]; }
            float kS = kS0 + kS1; kS += __shfl_xor(kS, 1); kS += __shfl_xor(kS, 2);
            const float e = eg[t], c = be[t] * (vs[t * 128 + dv] - e * kS);
            float o0 = 0.f, o1 = 0.f;
#pragma unroll
            for (int i = 0; i < 8; ++i) { const f32x4 qv = qp[i];
                S[4 * i] = e * S[4 * i] + kv[i].x * c; S[4 * i + 1] = e * S[4 * i + 1] + kv[i].y * c; S[4 * i + 2] = e * S[4 * i + 2] + kv[i].z * c; S[4 * i + 3] = e * S[4 * i + 3] + kv[i].w * c;
                o0 += qv.x * S[4 * i] + qv.y * S[4 * i + 1]; o1 += qv.z * S[4 * i + 2] + qv.w * S[4 * i + 3]; }
            float ov = o0 + o1; ov += __shfl_xor(ov, 1); ov += __shfl_xor(ov, 2);
            if (part == 0) os[t * 128 + dv] = ov;
        }
        __syncthreads();
#pragma unroll
        for (int it = 0; it < 2; ++it) { const int item = tid + 512 * it, row = item >> 4, sg = item & 15;
            const LAS float* op = os + row * 128 + sg * 8; const f32x4 o0 = *(const LAS f32x4*)op, o1 = *(const LAS f32x4*)(op + 4);
            float ss = (o0.x * o0.x + o0.y * o0.y) + (o0.z * o0.z + o0.w * o0.w) + (o1.x * o1.x + o1.y * o1.y) + (o1.z * o1.z + o1.w * o1.w);
            ss += __shfl_xor(ss, 1); ss += __shfl_xor(ss, 2); ss += __shfl_xor(ss, 4); ss += __shfl_xor(ss, 8);
            const float rstd = 1.0f / sqrtf(ss * (1.0f / 128.0f) + EPS);
            const size_t off = ((size_t)(b * SEQ + n * 64 + row)) * 1024 + h * 128 + sg * 8;
            float g[8]; unpack8(*(const u32x4*)(GATE + off), g);
            const f32x4 w0 = *(const f32x4*)(a.in[9] + sg * 8), w1 = *(const f32x4*)(a.in[9] + sg * 8 + 4);
            float r[8] = {o0.x * rstd * w0.x * g[0], o0.y * rstd * w0.y * g[1], o0.z * rstd * w0.z * g[2], o0.w * rstd * w0.w * g[3],
                          o1.x * rstd * w1.x * g[4], o1.y * rstd * w1.y * g[5], o1.z * rstd * w1.z * g[6], o1.w * rstd * w1.w * g[7]};
            *(u32x4*)(OB + off) = pack8(r); }
        __syncthreads();
    }
}

constexpr int G_QS = 0, G_KS = 17408, G_KTS = 34816, G_VTS = 53248, G_NB = 71680, G_ATT = 126976, G_VEC = 136192, G_OT = 137472;
constexpr int P128 = 136, P64 = 72;
DI bf16x8 pack_frag_hw(const f32x16& x, int s) { u32x4 p; p.x = pkbf(x[8 * s], x[8 * s + 1]); p.y = pkbf(x[8 * s + 2], x[8 * s + 3]); p.z = pkbf(x[8 * s + 4], x[8 * s + 5]); p.w = pkbf(x[8 * s + 6], x[8 * s + 7]); return __builtin_bit_cast(bf16x8, p); }
DI f32x16 zero16() { f32x16 z;
#pragma unroll
    for (int r = 0; r < 16; ++r) z[r] = 0.f;
    return z; }
DI f32x16 mma_tile(const LAS bf16* A, int lda, const LAS bf16* Bt, int ldb, int ksteps, f32x16 acc, int r32, int hi) {
    for (int s = 0; s < ksteps; ++s) { const bf16x8 af = *(const LAS bf16x8*)(A + r32 * lda + 16 * s + 8 * hi); const bf16x8 bf = *(const LAS bf16x8*)(Bt + r32 * ldb + 16 * s + 8 * hi); acc = MFMA32(af, bf, acc); }
    return acc; }
DI bf16x8 afrag_perm(const LAS bf16* A, int lda, int row, int kb, int hi) { const LAS bf16* p = A + row * lda + kb + 4 * hi; const u32x2 lo = *(const LAS u32x2*)p, h2 = *(const LAS u32x2*)(p + 8);
    u32x4 t; t.x = lo.x; t.y = lo.y; t.z = h2.x; t.w = h2.y; return __builtin_bit_cast(bf16x8, t); }
DI void store_T(LAS bf16* dst, int ld, const f32x16& v, int r32, int hi) {
#pragma unroll
    for (int q = 0; q < 4; ++q) { u32x2 w; w.x = pkbf(v[4 * q], v[4 * q + 1]); w.y = pkbf(v[4 * q + 2], v[4 * q + 3]); *(LAS u32x2*)(dst + r32 * ld + 8 * q + 4 * hi) = w; } }


DI float row16_sum(float x) {
    x += __builtin_bit_cast(float, __builtin_amdgcn_update_dpp(0, __builtin_bit_cast(int, x), 0x128, 0xf, 0xf, false));
    x += __builtin_bit_cast(float, __builtin_amdgcn_update_dpp(0, __builtin_bit_cast(int, x), 0x124, 0xf, 0xf, false));
    x += __builtin_bit_cast(float, __builtin_amdgcn_update_dpp(0, __builtin_bit_cast(int, x), 0x122, 0xf, 0xf, false));
    x += __builtin_bit_cast(float, __builtin_amdgcn_update_dpp(0, __builtin_bit_cast(int, x), 0x121, 0xf, 0xf, false));
    return x; }
DI float lane_read(float v, int srclane) { return __builtin_bit_cast(float, __builtin_amdgcn_ds_bpermute(srclane << 2, __builtin_bit_cast(int, v))); }
DI void store_N(LAS bf16* dst, int ld, const f32x16& v, int r32, int hi) {
#pragma unroll
    for (int q = 0; q < 4; ++q) { const unsigned w0 = pkbf(v[4 * q], v[4 * q + 1]), w1 = pkbf(v[4 * q + 2], v[4 * q + 3]); LAS bf16* p = dst + (8 * q + 4 * hi) * ld + r32;
        p[0] = (bf16)(w0 & 0xffffu); p[ld] = (bf16)(w0 >> 16); p[2 * ld] = (bf16)(w1 & 0xffffu); p[3 * ld] = (bf16)(w1 >> 16); } }
DI unsigned yp_get_(const f32x16 (&R)[4], int r, int c) { const float f = R[r >> 2][4 * (r & 3) + c]; return __builtin_bit_cast(unsigned, f); }
#define YP_GET(R, r, c) yp_get_(R, r, c)
#define YP_SET(R, r, c, v) do { const unsigned yv_ = (unsigned)(v); const float yf_ = __builtin_bit_cast(float, yv_); (R)[(r) >> 2][4 * ((r) & 3) + (c)] = yf_; } while (0)
struct GdnRaw { u32x4 ex[3]; };
DI void gdn_stage_issue(const Args& a, int b, int h, int n, int wave, int lane, GdnRaw& raw, f32x16 (&R)[4]) {
    unsigned char* ws = a.ws;
    if (wave == 4) { const size_t row = (size_t)(b * SEQ + n * 64 + lane); const float* AB = (const float*)(ws + WS_AB); R[0][0] = AB[row * 16 + h]; R[0][1] = AB[row * 16 + 8 + h]; }
    else if (wave >= 5) {
        const int tens = wave - 5, seg = lane & 15, rblk = lane >> 4;
        const bf16* src = (const bf16*)(ws + WS_QB + (size_t)tens * (WS_KB - WS_QB)) + ((size_t)(b * SEQ + n * 64 + rblk * 16)) * 1024 + h * 128 + seg * 8;
        const bool zhalo = (n == 0) && (rblk == 0);
#pragma unroll
        for (int i = 0; i < 19; ++i) { u32x4 v = *(const u32x4*)(src + (ptrdiff_t)(i - 3) * 1024); if (i < 3 && zhalo) v = (u32x4){0u, 0u, 0u, 0u};
            if (i < 16) { YP_SET(R, i, 0, v.x); YP_SET(R, i, 1, v.y); YP_SET(R, i, 2, v.z); YP_SET(R, i, 3, v.w); } else raw.ex[i - 16] = v; }
    }
}
#define RAWROW(i) ((i) < 16 ? (u32x4){YP_GET(R, (i) & 15, 0), YP_GET(R, (i) & 15, 1), YP_GET(R, (i) & 15, 2), YP_GET(R, (i) & 15, 3)} : raw.ex[((i) - 16) < 0 ? 0 : (i) - 16])
template <int HALF> DI void gdn_stage_compute(const Args& a, int h, int wave, int lane, const GdnRaw& raw, f32x16 (&R)[4]) {
    if (wave >= 5) {
        const int tens = wave - 5, seg = lane & 15;
        float cw[4][8];
#pragma unroll
        for (int i = 0; i < 4; ++i) { const float* cp = a.in[6] + (size_t)i * 3072 + tens * 1024 + h * 128 + seg * 8; const f32x4 c0 = *(const f32x4*)cp, c1 = *(const f32x4*)(cp + 4);
            cw[i][0] = c0.x; cw[i][1] = c0.y; cw[i][2] = c0.z; cw[i][3] = c0.w; cw[i][4] = c1.x; cw[i][5] = c1.y; cw[i][6] = c1.z; cw[i][7] = c1.w; }
        float x0[8], x1[8], x2[8], x3[8];
        constexpr int R0 = (HALF == 1) ? 8 : 0, R1 = (HALF == 0) ? 8 : 16;
        unpack8(RAWROW(R0), x0); unpack8(RAWROW(R0 + 1), x1); unpack8(RAWROW(R0 + 2), x2);
#pragma unroll
        for (int r = R0; r < R1; ++r) {
            unpack8(RAWROW(r + 3), x3);
            float y[8]; float ss = 0.f;
#pragma unroll
            for (int j = 0; j < 8; ++j) { float v = cw[0][j] * x0[j] + cw[1][j] * x1[j] + cw[2][j] * x2[j] + cw[3][j] * x3[j];
                v = v * __builtin_amdgcn_rcpf(1.0f + __builtin_amdgcn_exp2f(-1.4426950408889634f * v)); y[j] = v; ss += v * v; x0[j] = x1[j]; x1[j] = x2[j]; x2[j] = x3[j]; }
            if (tens < 2) { ss = row16_sum(ss);
                const float sc = (tens == 0 ? 0.08838834764831845f : 1.0f) * __builtin_amdgcn_rsqf(ss + EPS);
#pragma unroll
                for (int j = 0; j < 8; ++j) y[j] *= sc; }
            YP_SET(R, r, 0, pg8::cvt_pk_bf16(y[0], y[1])); YP_SET(R, r, 1, pg8::cvt_pk_bf16(y[2], y[3])); YP_SET(R, r, 2, pg8::cvt_pk_bf16(y[4], y[5])); YP_SET(R, r, 3, pg8::cvt_pk_bf16(y[6], y[7]));
        }
    }
}
DI unsigned perm_lo(unsigned a, unsigned b) { return (a & 0xffffu) | (b << 16); }
DI unsigned perm_hi(unsigned a, unsigned b) { return (a >> 16) | (b & 0xffff0000u); }
DI void gdn_stage_write(LAS unsigned char* lds, int wave, int lane, const f32x16 (&R)[4]) {
    if (wave == 4) {
        LAS float* vec = (LAS float*)(lds + G_VEC);
        float gc = R[0][0];
#pragma unroll
        for (int o = 1; o < 64; o <<= 1) { const float t = lane_read(gc, lane - o); if (lane >= o) gc += t; }
        const float gl = lane_read(gc, 63);
        vec[lane] = gc; vec[64 + lane] = R[0][1]; vec[128 + lane] = __expf(gc); vec[192 + lane] = __expf(gl - gc); if (lane == 0) vec[256] = __expf(gl);
    } else if (wave >= 5) {
        const int tens = wave - 5, seg = lane & 15, rblk = lane >> 4;
        if (tens < 2) { LAS bf16* dst = (LAS bf16*)(lds + (tens == 0 ? G_QS : G_KS)) + (rblk * 16) * P128 + seg * 8;
#pragma unroll
            for (int r = 0; r < 16; ++r) *(LAS u32x4*)(dst + r * P128) = (u32x4){YP_GET(R, r, 0), YP_GET(R, r, 1), YP_GET(R, r, 2), YP_GET(R, r, 3)}; }
        if (tens >= 1) { LAS bf16* dst = (LAS bf16*)(lds + (tens == 1 ? G_KTS : G_VTS)) + (seg * 8) * P64 + rblk * 16;
#pragma unroll
            for (int jp = 0; jp < 4; ++jp) {
                unsigned lo[8], hi2[8];
#pragma unroll
                for (int rp = 0; rp < 8; ++rp) { const unsigned a0 = YP_GET(R, 2 * rp, jp), a1 = YP_GET(R, 2 * rp + 1, jp); lo[rp] = perm_lo(a0, a1); hi2[rp] = perm_hi(a0, a1); }
                *(LAS u32x4*)(dst + (2 * jp) * P64) = (u32x4){lo[0], lo[1], lo[2], lo[3]}; *(LAS u32x4*)(dst + (2 * jp) * P64 + 8) = (u32x4){lo[4], lo[5], lo[6], lo[7]};
                *(LAS u32x4*)(dst + (2 * jp + 1) * P64) = (u32x4){hi2[0], hi2[1], hi2[2], hi2[3]}; *(LAS u32x4*)(dst + (2 * jp + 1) * P64 + 8) = (u32x4){hi2[4], hi2[5], hi2[6], hi2[7]};
            } }
    }
}

DI void gdn_output(const Args& a, int b, int h, int nchunk, int ltid, const LAS bf16* OT, const u32x4 (&gq)[8], bf16* OB) {
    const int sg = ltid & 15, rw = ltid >> 4;
    const f32x4 w0 = *(const f32x4*)(a.in[9] + sg * 8), w1 = *(const f32x4*)(a.in[9] + sg * 8 + 4);
    const float nw[8] = {w0.x, w0.y, w0.z, w0.w, w1.x, w1.y, w1.z, w1.w};
#pragma unroll
    for (int it = 0; it < 8; ++it) { float o[8], g8[8]; unpack8(*(const LAS u32x4*)(OT + (rw + 8 * it) * P128 + sg * 8), o);
        float ss = 0.f;
#pragma unroll
        for (int e = 0; e < 8; ++e) ss += o[e] * o[e];
        ss = row16_sum(ss);
        const float rstd = __builtin_amdgcn_rsqf(ss * (1.0f / 128.0f) + EPS);
        unpack8(gq[it], g8);
#pragma unroll
        for (int e = 0; e < 8; ++e) o[e] = o[e] * rstd * nw[e] * g8[e];
        *(u32x4*)(OB + ((size_t)(b * SEQ + nchunk * 64 + rw + 8 * it)) * 1024 + h * 128 + sg * 8) = pack8(o); }
}
DI void gdn_gate_prefetch(const Args& a, int b, int h, int nchunk, int ltid, u32x4 (&gq)[8]) {
    const bf16* GATE = (const bf16*)a.out + (size_t)M * DM; const int sg = ltid & 15, rw = ltid >> 4;
#pragma unroll
    for (int it = 0; it < 8; ++it) gq[it] = *(const u32x4*)(GATE + ((size_t)(b * SEQ + nchunk * 64 + rw + 8 * it)) * 1024 + h * 128 + sg * 8);
}
DI int gdn_chunked(const Args& a, int bh, LAS unsigned char* lds, int wave, int lane, bf16* OBdst) {
    int failcode = 0; const int ctid = wave * 64 + lane; const int cc = ctid & 63, cpart = ctid >> 6; (void)cc; (void)cpart;
    const int b = bh >> 3, h = bh & 7; const int lane0 = lane;
    unsigned char* ws = a.ws;
#define GDN_OPAQUE_LANE() int lane = lane0; asm volatile("" : "+v"(lane)); const int r32 = lane & 31, hi = lane >> 5; (void)r32; (void)hi
    LAS bf16* Qs = (LAS bf16*)(lds + G_QS); LAS bf16* Ks = (LAS bf16*)(lds + G_KS); LAS bf16* KTs = (LAS bf16*)(lds + G_KTS); LAS bf16* VTs = (LAS bf16*)(lds + G_VTS);
    LAS bf16* NB = (LAS bf16*)(lds + G_NB); LAS bf16* ATT = (LAS bf16*)(lds + G_ATT); LAS bf16* OT = (LAS bf16*)(lds + G_OT);
    LAS float* VGC = (LAS float*)(lds + G_VEC); LAS float* VBE = VGC + 64; LAS float* VEG = VGC + 128; LAS float* VDL = VGC + 192;
    constexpr int NBQ = 9216 / 2;
    f32x16 Sacc[4];
#pragma unroll
    for (int k = 0; k < 4; ++k) Sacc[k] = zero16();
    GdnRaw raw;
    gdn_stage_issue(a, b, h, 0, wave, lane0, raw, Sacc);
    gdn_stage_compute<2>(a, h, wave, lane0, raw, Sacc);
    gdn_stage_write(lds, wave, lane0, Sacc);
    if (GDN_NCHUNK > 1) gdn_stage_issue(a, b, h, 1, wave, lane0, raw, Sacc);
    __syncthreads();
    if (wave < 4) {
#pragma unroll
        for (int k = 0; k < 4; ++k) Sacc[k] = zero16(); }

    u32x4 gq[8];
    for (int n = 0; n < GDN_NCHUNK; ++n) {
        for (int pa_ = (MK_PROBE == 23) ? 0 : 1; pa_ < 2; ++pa_) {
        if (wave < 2) {
            GDN_OPAQUE_LANE();
            const int d = wave, blk = (32 * d) * P64 + 32 * d;
            {
                f32x16 acc = mma_tile(Ks + 32 * d * P128, P128, Ks + 32 * d * P128, P128, 8, zero16(), r32, hi);
                const int jj = 32 * d + r32; const float gj = VGC[jj];
#pragma unroll
                for (int q = 0; q < 4; ++q) { const int i0 = 32 * d + 8 * q + 4 * hi; const f32x4 gi = *(const LAS f32x4*)(VGC + i0), bei = *(const LAS f32x4*)(VBE + i0);
#pragma unroll
                    for (int e = 0; e < 4; ++e) acc[4 * q + e] = (i0 + e > jj) ? -bei[e] * acc[4 * q + e] * __expf(gi[e] - gj) : 0.f; }
                store_T(NB + 2 * NBQ + blk, P64, acc, r32, hi);
            }
            {
                f32x16 acc = mma_tile(Ks + 32 * d * P128, P128, Ks + 32 * d * P128, P128, 8, zero16(), r32, hi);
                const int ii = 32 * d + r32; const float gi = VGC[ii], bei = VBE[ii]; f32x16 p0;
#pragma unroll
                for (int q = 0; q < 4; ++q) { const int j0 = 32 * d + 8 * q + 4 * hi; const f32x4 gj = *(const LAS f32x4*)(VGC + j0);
#pragma unroll
                    for (int e = 0; e < 4; ++e) { const int jj = j0 + e; const float v = (ii > jj) ? -bei * acc[4 * q + e] * __expf(gi - gj[e]) : 0.f; acc[4 * q + e] = v; p0[4 * q + e] = v + ((ii == jj) ? 1.0f : 0.f); } }
                store_T(NB + blk, P64, acc, r32, hi); store_T(NB + 4 * NBQ + blk, P64, p0, r32, hi);
            }
            asm volatile("s_waitcnt lgkmcnt(0)" ::: "memory");
#pragma unroll 1
            for (int rd = 1; rd <= 5; ++rd) {
                const int qs = (rd - 1) & 1, qd = rd & 1, ps = rd & 1, pd = (rd & 1) ^ 1;
                const LAS bf16* Qn_s = NB + qs * NBQ + blk; const LAS bf16* Qt_s = NB + (2 + qs) * NBQ + blk; const LAS bf16* Pn_s = NB + (4 + ps) * NBQ + blk;
                LAS bf16* Qn_d = NB + qd * NBQ + blk; LAS bf16* Qt_d = NB + (2 + qd) * NBQ + blk; LAS bf16* Pn_d = NB + (4 + pd) * NBQ + blk;
                const bf16x8 qt0 = *(const LAS bf16x8*)(Qt_s + r32 * P64 + 8 * hi), qt1 = *(const LAS bf16x8*)(Qt_s + r32 * P64 + 16 + 8 * hi);
                const bf16x8 qn0 = *(const LAS bf16x8*)(Qn_s + r32 * P64 + 8 * hi), qn1 = *(const LAS bf16x8*)(Qn_s + r32 * P64 + 16 + 8 * hi);
                const bf16x8 pn0 = *(const LAS bf16x8*)(Pn_s + r32 * P64 + 8 * hi), pn1 = *(const LAS bf16x8*)(Pn_s + r32 * P64 + 16 + 8 * hi);
                u32x2 pv[4];
#pragma unroll
                for (int q = 0; q < 4; ++q) pv[q] = *(const LAS u32x2*)(Pn_s + r32 * P64 + 8 * q + 4 * hi);
                f32x16 a0 = zero16(), a1 = zero16(), a2 = zero16();
                if (rd <= 4) { a0 = MFMA32(qt0, qn0, a0); a1 = MFMA32(qn0, qt0, a1); }
                if (rd >= 2) a2 = MFMA32(qt0, pn0, a2);
                if (rd <= 4) { a0 = MFMA32(qt1, qn1, a0); a1 = MFMA32(qn1, qt1, a1); }
                if (rd >= 2) a2 = MFMA32(qt1, pn1, a2);
                if (rd <= 4) { store_T(Qn_d, P64, a0, r32, hi); store_T(Qt_d, P64, a1, r32, hi); }
                if (rd >= 2) {
#pragma unroll
                    for (int q = 0; q < 4; ++q) { a2[4 * q] += bflo(pv[q].x); a2[4 * q + 1] += bfhi(pv[q].x); a2[4 * q + 2] += bflo(pv[q].y); a2[4 * q + 3] += bfhi(pv[q].y); }
                    store_T(Pn_d, P64, a2, r32, hi); }
                asm volatile("s_waitcnt lgkmcnt(0)" ::: "memory");
            }
        } else if (wave == 2) {
            GDN_OPAQUE_LANE();
            f32x16 acc = mma_tile(Ks, P128, Ks + 32 * P128, P128, 8, zero16(), r32, hi);
            const int ii = 32 + r32; const float gi = VGC[ii], bei = VBE[ii];
#pragma unroll
            for (int q = 0; q < 4; ++q) { const int j0 = 8 * q + 4 * hi; const f32x4 gj = *(const LAS f32x4*)(VGC + j0);
#pragma unroll
                for (int e = 0; e < 4; ++e) acc[4 * q + e] = -bei * acc[4 * q + e] * __expf(gi - gj[e]); }
            store_T(NB + 32 * P64, P64, acc, r32, hi);
        }
        if (wave >= 2 && wave < 5) {
            GDN_OPAQUE_LANE();
            const int bi = (wave == 3) ? 0 : 1, bj = (wave == 2) ? 1 : 0;
            f32x16 acc = mma_tile(Ks + 32 * bj * P128, P128, Qs + 32 * bi * P128, P128, 8, zero16(), r32, hi);
            const int ii = 32 * bi + r32; const float gi = VGC[ii];
#pragma unroll
            for (int q = 0; q < 4; ++q) { const int j0 = 32 * bj + 8 * q + 4 * hi; const f32x4 gj = *(const LAS f32x4*)(VGC + j0);
#pragma unroll
                for (int e = 0; e < 4; ++e) acc[4 * q + e] = (ii >= j0 + e) ? acc[4 * q + e] * __expf(gi - gj[e]) : 0.f; }
            store_T(ATT + (32 * bi) * P64 + 32 * bj, P64, acc, r32, hi);
        }
        if ((wave == 2 || wave == 3) && n > 0) { GDN_OPAQUE_LANE(); gdn_output(a, b, h, n - 1, (wave - 2) * 64 + lane, OT, gq, OBdst); }
        if (pa_ == 0) __syncthreads();
        }
        if (wave >= 5 && n + 1 < GDN_NCHUNK) { GDN_OPAQUE_LANE(); gdn_stage_compute<0>(a, h, wave, lane, raw, Sacc); }
        __syncthreads();
        const LAS bf16* Tm = NB + 4 * NBQ;
        if (wave < 4) {
          for (int sc_ = (MK_PROBE == 26) ? 0 : 1; sc_ < 2; ++sc_) {
            GDN_OPAQUE_LANE();
            const int dv0 = 32 * wave;
            bf16x8 sf[8];
#pragma unroll
            for (int s = 0; s < 8; ++s) sf[s] = pack_frag_hw(Sacc[s >> 1], s & 1);
            f32x16 X[2], OQ[2];
#pragma unroll
            for (int mi = 0; mi < 2; ++mi) { X[mi] = zero16(); OQ[mi] = zero16();
#pragma unroll
                for (int s = 0; s < 8; ++s) { X[mi] = MFMA32(afrag_perm(Ks, P128, 32 * mi + r32, 16 * s, hi), sf[s], X[mi]); OQ[mi] = MFMA32(afrag_perm(Qs, P128, 32 * mi + r32, 16 * s, hi), sf[s], OQ[mi]); } }
#pragma unroll
            for (int mi = 0; mi < 2; ++mi)
#pragma unroll
                for (int q = 0; q < 4; ++q) { const int c0 = 32 * mi + 8 * q + 4 * hi; const f32x4 b4 = *(const LAS f32x4*)(VBE + c0), e4 = *(const LAS f32x4*)(VEG + c0);
                    const u32x2 vv = *(const LAS u32x2*)(VTs + (dv0 + r32) * P64 + c0); const float v4[4] = {bflo(vv.x), bfhi(vv.x), bflo(vv.y), bfhi(vv.y)};
#pragma unroll
                    for (int e = 0; e < 4; ++e) { X[mi][4 * q + e] = b4[e] * (v4[e] - e4[e] * X[mi][4 * q + e]); OQ[mi][4 * q + e] *= e4[e]; } }
            f32x16 VN[2];
            { const bf16x8 y00 = pack_frag_hw(X[0], 0), y01 = pack_frag_hw(X[0], 1), y10 = pack_frag_hw(X[1], 0), y11 = pack_frag_hw(X[1], 1);
              VN[0] = MFMA32(afrag_perm(Tm, P64, r32, 0, hi), y00, zero16()); VN[0] = MFMA32(afrag_perm(Tm, P64, r32, 16, hi), y01, VN[0]);
              const bf16x8 n00 = pack_frag_hw(VN[0], 0), n01 = pack_frag_hw(VN[0], 1);
              f32x16 Z = MFMA32(afrag_perm(NB, P64, 32 + r32, 0, hi), n00, X[1]); Z = MFMA32(afrag_perm(NB, P64, 32 + r32, 16, hi), n01, Z);
              const bf16x8 z0 = pack_frag_hw(Z, 0), z1 = pack_frag_hw(Z, 1);
              VN[1] = MFMA32(afrag_perm(Tm, P64, 32 + r32, 32, hi), z0, zero16()); VN[1] = MFMA32(afrag_perm(Tm, P64, 32 + r32, 48, hi), z1, VN[1]); (void)y10; (void)y11; }
            { const bf16x8 v00 = pack_frag_hw(VN[0], 0), v01 = pack_frag_hw(VN[0], 1), v10 = pack_frag_hw(VN[1], 0), v11 = pack_frag_hw(VN[1], 1);
              OQ[0] = MFMA32(afrag_perm(ATT, P64, r32, 0, hi), v00, OQ[0]); OQ[0] = MFMA32(afrag_perm(ATT, P64, r32, 16, hi), v01, OQ[0]);
              OQ[1] = MFMA32(afrag_perm(ATT, P64, 32 + r32, 0, hi), v00, OQ[1]); OQ[1] = MFMA32(afrag_perm(ATT, P64, 32 + r32, 16, hi), v01, OQ[1]);
              OQ[1] = MFMA32(afrag_perm(ATT, P64, 32 + r32, 32, hi), v10, OQ[1]); OQ[1] = MFMA32(afrag_perm(ATT, P64, 32 + r32, 48, hi), v11, OQ[1]); }
#pragma unroll
            for (int mi = 0; mi < 2; ++mi)
#pragma unroll
                for (int q = 0; q < 4; ++q) { const f32x4 d4 = *(const LAS f32x4*)(VDL + 32 * mi + 8 * q + 4 * hi);
#pragma unroll
                    for (int e = 0; e < 4; ++e) VN[mi][4 * q + e] *= d4[e]; }
            if (sc_ == 1) { const float egl = VGC[256];
              const bf16x8 w0 = pack_frag_hw(VN[0], 0), w1 = pack_frag_hw(VN[0], 1), w2 = pack_frag_hw(VN[1], 0), w3 = pack_frag_hw(VN[1], 1);
#pragma unroll
              for (int kb = 0; kb < 4; ++kb) {
#pragma unroll
                  for (int r = 0; r < 16; ++r) Sacc[kb][r] *= egl;
                  Sacc[kb] = MFMA32(afrag_perm(KTs, P64, 32 * kb + r32, 0, hi), w0, Sacc[kb]); Sacc[kb] = MFMA32(afrag_perm(KTs, P64, 32 * kb + r32, 16, hi), w1, Sacc[kb]);
                  Sacc[kb] = MFMA32(afrag_perm(KTs, P64, 32 * kb + r32, 32, hi), w2, Sacc[kb]); Sacc[kb] = MFMA32(afrag_perm(KTs, P64, 32 * kb + r32, 48, hi), w3, Sacc[kb]); } }
            store_N(OT + dv0, P128, OQ[0], r32, hi); store_N(OT + 32 * P128 + dv0, P128, OQ[1], r32, hi);
          }
        } else {
            GDN_OPAQUE_LANE();
            if (wave >= 5 && n + 1 < GDN_NCHUNK) gdn_stage_compute<1>(a, h, wave, lane, raw, Sacc);
        }
        __syncthreads();

        if (wave == 2 || wave == 3) { GDN_OPAQUE_LANE(); gdn_gate_prefetch(a, b, h, n, (wave - 2) * 64 + lane, gq); }
        for (int pd_ = (MK_PROBE == 25) ? 0 : 1; pd_ < 2; ++pd_) {
        if (wave >= 4 && n + 1 < GDN_NCHUNK) { GDN_OPAQUE_LANE(); gdn_stage_write(lds, wave, lane, Sacc); if (n + 2 < GDN_NCHUNK && pd_ == 1) gdn_stage_issue(a, b, h, n + 2, wave, lane, raw, Sacc); }
        if (pd_ == 0) __syncthreads();
        }
        __syncthreads();
    }
    if (wave == 2 || wave == 3) { GDN_OPAQUE_LANE(); gdn_output(a, b, h, GDN_NCHUNK - 1, (wave - 2) * 64 + lane, OT, gq, OBdst); }
    __syncthreads();
    return failcode;
}

DI unsigned sortable(float f) { const unsigned u = __builtin_bit_cast(unsigned, f); return (u & 0x80000000u) ? ~u : (u | 0x80000000u); }
DI float unsortable(unsigned k) { const unsigned u = (k & 0x80000000u) ? (k & 0x7fffffffu) : ~k; return __builtin_bit_cast(float, u); }
#define CE_DESC(x, y) do { const unsigned _a = (x), _b = (y); (x) = _a > _b ? _a : _b; (y) = _a > _b ? _b : _a; } while (0)
#define CE_ASC(x, y) do { const unsigned _a = (x), _b = (y); (x) = _a > _b ? _b : _a; (y) = _a > _b ? _a : _b; } while (0)
DI void sort16_desc(unsigned (&v)[16]) { CE_DESC(v[0], v[1]); CE_DESC(v[2], v[3]); CE_DESC(v[0], v[2]); CE_DESC(v[1], v[3]); CE_DESC(v[1], v[2]); CE_DESC(v[4], v[5]); CE_DESC(v[6], v[7]); CE_DESC(v[4], v[6]); CE_DESC(v[5], v[7]); CE_DESC(v[5], v[6]); CE_DESC(v[0], v[4]); CE_DESC(v[2], v[6]); CE_DESC(v[2], v[4]); CE_DESC(v[1], v[5]); CE_DESC(v[3], v[7]); CE_DESC(v[3], v[5]); CE_DESC(v[1], v[2]); CE_DESC(v[3], v[4]); CE_DESC(v[5], v[6]); CE_DESC(v[8], v[9]); CE_DESC(v[10], v[11]); CE_DESC(v[8], v[10]); CE_DESC(v[9], v[11]); CE_DESC(v[9], v[10]); CE_DESC(v[12], v[13]); CE_DESC(v[14], v[15]); CE_DESC(v[12], v[14]); CE_DESC(v[13], v[15]); CE_DESC(v[13], v[14]); CE_DESC(v[8], v[12]); CE_DESC(v[10], v[14]); CE_DESC(v[10], v[12]); CE_DESC(v[9], v[13]); CE_DESC(v[11], v[15]); CE_DESC(v[11], v[13]); CE_DESC(v[9], v[10]); CE_DESC(v[11], v[12]); CE_DESC(v[13], v[14]); CE_DESC(v[0], v[8]); CE_DESC(v[4], v[12]); CE_DESC(v[4], v[8]); CE_DESC(v[2], v[10]); CE_DESC(v[6], v[14]); CE_DESC(v[6], v[10]); CE_DESC(v[2], v[4]); CE_DESC(v[6], v[8]); CE_DESC(v[10], v[12]); CE_DESC(v[1], v[9]); CE_DESC(v[5], v[13]); CE_DESC(v[5], v[9]); CE_DESC(v[3], v[11]); CE_DESC(v[7], v[15]); CE_DESC(v[7], v[11]); CE_DESC(v[3], v[5]); CE_DESC(v[7], v[9]); CE_DESC(v[11], v[13]); CE_DESC(v[1], v[2]); CE_DESC(v[3], v[4]); CE_DESC(v[5], v[6]); CE_DESC(v[7], v[8]); CE_DESC(v[9], v[10]); CE_DESC(v[11], v[12]); CE_DESC(v[13], v[14]); }
DI void merge8x8_desc(unsigned (&v)[16]) { CE_DESC(v[0], v[8]); CE_DESC(v[4], v[12]); CE_DESC(v[4], v[8]); CE_DESC(v[2], v[10]); CE_DESC(v[6], v[14]); CE_DESC(v[6], v[10]); CE_DESC(v[2], v[4]); CE_DESC(v[6], v[8]); CE_DESC(v[10], v[12]); CE_DESC(v[1], v[9]); CE_DESC(v[5], v[13]); CE_DESC(v[5], v[9]); CE_DESC(v[3], v[11]); CE_DESC(v[7], v[15]); CE_DESC(v[7], v[11]); CE_DESC(v[3], v[5]); CE_DESC(v[7], v[9]); CE_DESC(v[11], v[13]); CE_DESC(v[1], v[2]); CE_DESC(v[3], v[4]); CE_DESC(v[5], v[6]); CE_DESC(v[7], v[8]); CE_DESC(v[9], v[10]); CE_DESC(v[11], v[12]); CE_DESC(v[13], v[14]); }
DI void bitonic_merge16_desc(unsigned (&v)[16]) {
#pragma unroll
    for (int j = 8; j > 0; j >>= 1)
#pragma unroll
        for (int i = 0; i < 16; ++i) { const int l = i ^ j; if (l > i) CE_DESC(v[i], v[l]); }
}
DI void merge_top16(unsigned (&x)[16], const unsigned (&y)[16]) {
#pragma unroll
    for (int i = 0; i < 16; ++i) x[i] = x[i] > y[15 - i] ? x[i] : y[15 - i];
    bitonic_merge16_desc(x);
}
DI void merge_top16_2(unsigned (&x)[16], unsigned y0, unsigned y1) { CE_DESC(x[0], y0); CE_DESC(x[8], y0); CE_DESC(x[4], x[8]); CE_DESC(x[12], y0); CE_DESC(x[6], x[10]); CE_DESC(x[2], x[4]); CE_DESC(x[6], x[8]); CE_DESC(x[10], x[12]); CE_DESC(x[14], y0); CE_DESC(x[1], y1); CE_DESC(x[9], y1); CE_DESC(x[5], x[9]); CE_DESC(x[13], y1); CE_DESC(x[7], x[11]); CE_DESC(x[3], x[5]); CE_DESC(x[7], x[9]); CE_DESC(x[11], x[13]); x[15] = x[15] > y1 ? x[15] : y1; CE_DESC(x[1], x[2]); CE_DESC(x[3], x[4]); CE_DESC(x[5], x[6]); CE_DESC(x[7], x[8]); CE_DESC(x[9], x[10]); CE_DESC(x[11], x[12]); CE_DESC(x[13], x[14]); x[15] = x[15] > y0 ? x[15] : y0;  }
DI void top16_of_64(const unsigned (&x)[64], unsigned (&out)[16]) {
    unsigned g[4][16];
#pragma unroll
    for (int q = 0; q < 4; ++q) {
#pragma unroll
        for (int i = 0; i < 16; ++i) g[q][i] = x[16 * q + i];
        sort16_desc(g[q]); }
    merge_top16(g[0], g[1]); merge_top16(g[2], g[3]); merge_top16(g[0], g[2]);
#pragma unroll
    for (int i = 0; i < 16; ++i) out[i] = g[0][i];
}
DI float gelu_exact(float x) { return 0.5f * x * (1.0f + erff(x * 0.7071067811865476f)); }

DI void route_scores_issue(const unsigned char* ws, int tile, int p, int head, int lane, LAS unsigned char* sbuf) {
    const char* gp = (const char*)(ws + WS_QP) + ((size_t)(tile * 32 + (lane & 31)) * 2048 + head * 256 + p * 128 + 64 * (lane >> 5)) * 2;
#pragma unroll
    for (int c8 = 0; c8 < 8; ++c8) __builtin_amdgcn_global_load_lds((const unsigned*)(gp + 16 * c8), (LAS unsigned*)(sbuf + c8 * 1024), 16, 0, 0);
}
DI void peer_route_tile(const Args& a, int tile, int q4, LAS unsigned char* lds, int wave, int lane_in) {
    int lane = lane_in; asm volatile("" : "+v"(lane));
    const int r32 = lane & 31, hi = lane >> 5, head = wave;
    unsigned char* ws = a.ws;
    LAS unsigned short* EIDX = (LAS unsigned short*)lds;
    LAS unsigned short* GATEH = (LAS unsigned short*)(lds + 32768);
    LAS unsigned char* scr = lds + 65536 + wave * 2048;
    LAS unsigned char* sbuf = lds + 81920 + wave * 8192;
    const float* SSQ = (const float*)(ws + WS_SSQ);
    const int token = tile * 32 + r32;
    float rstd;
    { const f32x4* sp = (const f32x4*)(SSQ + (size_t)token * 16); const f32x4 s0 = sp[0], s1 = sp[1], s2 = sp[2], s3 = sp[3];
      const float ssq = ((s0.x + s0.y) + (s0.z + s0.w)) + ((s1.x + s1.y) + (s1.z + s1.w)) + ((s2.x + s2.y) + (s2.z + s2.w)) + ((s3.x + s3.y) + (s3.z + s3.w));
      rstd = 1.0f / sqrtf(ssq * (1.0f / DM) + EPS); }
    unsigned top[2][16];
#pragma unroll
    for (int p = 0; p < 2; ++p) {
        unsigned key[64];
        u32x4 raw[8];
        asm volatile("s_waitcnt vmcnt(0)" ::: "memory");
#pragma unroll
        for (int c8 = 0; c8 < 8; ++c8) raw[c8] = *(const LAS u32x4*)(sbuf + c8 * 1024 + lane * 16);
        asm volatile("s_waitcnt lgkmcnt(0)" ::: "memory");
        if (!(q4 == 3 && p == 1)) route_scores_issue(ws, p == 0 ? tile : tile + 1, p ^ 1, head, lane, sbuf);
#pragma unroll
        for (int c8 = 0; c8 < 8; ++c8) { float f[8]; unpack8(raw[c8], f);
#pragma unroll
            for (int e = 0; e < 8; ++e) key[8 * c8 + e] = (sortable(f[e]) & ~127u) | (unsigned)(127 - (64 * hi + 8 * c8 + e)); }
        unsigned t16[16], o16[16];
        top16_of_64(key, t16);
#pragma unroll
        for (int i = 0; i < 16; ++i) o16[i] = (unsigned)__shfl_xor((int)t16[i], 32);
        merge_top16(t16, o16);
#pragma unroll
        for (int i = 0; i < 16; ++i) top[p][i] = t16[i];
    }
    unsigned tc[16];
    {
        float A[16], B[16];
#pragma unroll
        for (int i = 0; i < 16; ++i) { A[i] = unsortable(top[0][i] & ~127u); B[i] = unsortable(top[1][i] & ~127u); }
#define CKEY(aa, bb) ((sortable(A[aa] + B[bb]) & ~255u) | (unsigned)(255 - ((aa) * 16 + (bb))))
        unsigned G1[16], G2[16];
#pragma unroll
        for (int b = 0; b < 16; ++b) tc[b] = CKEY(0, b);
#pragma unroll
        for (int b = 0; b < 8; ++b) { G1[b] = CKEY(1, b); G1[8 + b] = CKEY(8 + b, 0); }
        merge8x8_desc(G1);
        G2[0] = CKEY(2, 0); G2[1] = CKEY(2, 1); G2[2] = CKEY(2, 2); G2[3] = CKEY(2, 3); G2[4] = CKEY(2, 4); G2[5] = CKEY(3, 0); G2[6] = CKEY(3, 1); G2[7] = CKEY(3, 2); G2[8] = CKEY(3, 3);
        G2[9] = CKEY(4, 0); G2[10] = CKEY(4, 1); G2[11] = CKEY(4, 2); G2[12] = CKEY(5, 0); G2[13] = CKEY(5, 1); G2[14] = CKEY(6, 0); G2[15] = CKEY(6, 1);
        sort16_desc(G2);
        merge_top16_2(G2, CKEY(7, 0), CKEY(7, 1));
        merge_top16(tc, G1); merge_top16(tc, G2);
#undef CKEY
    }
    float gt[16];
    { float sv[16]; float sum = 0.f;
#pragma unroll
      for (int i = 0; i < 16; ++i) sv[i] = unsortable(tc[i] & ~255u) * rstd;
#pragma unroll
      for (int i = 0; i < 16; ++i) { gt[i] = __expf(sv[i] - sv[0]); sum += gt[i]; }
      const float inv = 1.0f / sum;
#pragma unroll
      for (int i = 0; i < 16; ++i) gt[i] *= inv; }
    { LAS unsigned* sw = (LAS unsigned*)(scr + lane * 32);
#pragma unroll
      for (int p = 0; p < 2; ++p)
#pragma unroll
          for (int q = 0; q < 4; ++q) sw[p * 4 + q] = (~top[p][4 * q] & 127u) | ((~top[p][4 * q + 1] & 127u) << 8) | ((~top[p][4 * q + 2] & 127u) << 16) | ((~top[p][4 * q + 3] & 127u) << 24);
      asm volatile("s_waitcnt lgkmcnt(0)" ::: "memory");
#pragma unroll
      for (int i = 0; i < 16; ++i) { const unsigned pos = ~tc[i] & 255u; const unsigned i1 = scr[lane * 32 + (pos >> 4)], i2 = scr[lane * 32 + 16 + (pos & 15u)];
          if (hi == 0) { EIDX[(q4 * 32 + r32) * 128 + head * 16 + i] = (unsigned short)(i1 * 128u + i2); GATEH[(q4 * 32 + r32) * 128 + head * 16 + i] = (unsigned short)f2bf(gt[i]); } }
    }
    asm volatile("s_waitcnt lgkmcnt(0)" ::: "memory");
}

DI float dot2bf(unsigned w, unsigned x, float acc) { return __builtin_amdgcn_fdot2_f32_bf16(__builtin_bit_cast(bf16x2_t, w), __builtin_bit_cast(bf16x2_t, x), acc, false); }
#define DPP_I(x, ctrl) __builtin_amdgcn_update_dpp(0, (x), (ctrl), 0xf, 0xf, false)
DI void peer_group(const Args& a, int grp, LAS unsigned char* lds, int wave, int lane, bool dry) {
    unsigned char* ws = a.ws;
    LAS unsigned short* EIDX = (LAS unsigned short*)lds;
    LAS unsigned short* GATEH = (LAS unsigned short*)(lds + 32768);
    LAS int* DOTI = (LAS int*)(lds + 65536);
    LAS float* DOTS = (LAS float*)(lds + 65536);
    const float* SSQ = (const float*)(ws + WS_SSQ);
    for (int rr_ = (MK_PROBE == 70) ? 0 : 1; rr_ < 2; ++rr_)
    { if (rr_ == ((MK_PROBE == 70) ? 0 : 1)) {} route_scores_issue(ws, grp * 4, 0, wave, lane, lds + 81920 + wave * 8192);
    for (int q4 = 0; q4 < 4; ++q4) peer_route_tile(a, grp * 4 + q4, q4, lds, wave, lane); }
    __syncthreads();
    const int tl0 = wave * 16, g = lane >> 3, j = lane & 7;
    for (int dd_ = (MK_PROBE == 71) ? 0 : 1; dd_ < 2; ++dd_) {
#pragma unroll
    for (int i = 0; i < 8; ++i) *(LAS u32x4*)(DOTI + tl0 * 128 + i * 256 + lane * 4) = (u32x4){0u, 0u, 0u, 0u};
    asm volatile("s_waitcnt lgkmcnt(0)" ::: "memory");
    for (int sp = 0; sp < 8; ++sp) {
        const __amdgpu_buffer_rsrc_t rs = __builtin_amdgcn_make_buffer_rsrc((void*)(ws + WS_DOWN + (size_t)sp * (2 * MiB)), (short)0, (int)(2 * MiB), 0x00020000);
        for (int i = 0; i < 16; ++i) {
            const int tl = tl0 + i; const size_t tok = (size_t)grp * 128 + tl;
            const u32x4 xq = *(const u32x4*)(ws + WS_X2Q + tok * 1024 + 128 * sp + 16 * j);
            u32x4 r[16];
#pragma unroll
            for (int ii = 0; ii < 16; ++ii) r[ii] = bload16(rs, (unsigned)EIDX[tl * 128 + 8 * ii + g] * 128u + 16u * j);
            int part0 = 0, part1 = 0;
#pragma unroll
            for (int ii = 0; ii < 16; ++ii) {
                int p = __builtin_amdgcn_sdot4((int)r[ii].x, (int)xq.x, 0, false); p = __builtin_amdgcn_sdot4((int)r[ii].y, (int)xq.y, p, false);
                p = __builtin_amdgcn_sdot4((int)r[ii].z, (int)xq.z, p, false); p = __builtin_amdgcn_sdot4((int)r[ii].w, (int)xq.w, p, false);
                p += DPP_I(p, 0xB1); p += DPP_I(p, 0x4E); p += DPP_I(p, 0x141);
                if (ii < 8) part0 += ((ii & 7) == j) ? p : 0; else part1 += ((ii & 7) == j) ? p : 0;
            }
            LAS int* dp = DOTI + tl * 128 + 8 * j + g;
            dp[0] += part0; dp[64] += part1;
        }
    }
    }
    asm volatile("s_waitcnt lgkmcnt(0)" ::: "memory");
    for (int i = 0; i < 16; ++i) {
        const int tl = tl0 + i; const size_t tok = (size_t)grp * 128 + tl;
        const float rstd_t = 1.0f / sqrtf(wave_sum(lane < 16 ? SSQ[tok * 16 + lane] : 0.f) * (1.0f / DM) + EPS) * ((const float*)(ws + WS_XSC))[tok];
#pragma unroll
        for (int q = 0; q < 2; ++q) { const int sl = tl * 128 + 64 * q + lane; const unsigned e = EIDX[sl];
            const float d = (float)DOTI[sl] * ((const float*)(ws + WS_DSC))[e] * rstd_t;
            DOTS[sl] = bflo((unsigned)GATEH[sl]) * gelu_exact(d) * ((const float*)(ws + WS_USC))[e]; }
    }
    asm volatile("s_waitcnt lgkmcnt(0)" ::: "memory");
    for (int uu_ = (MK_PROBE == 72) ? 0 : 1; uu_ < 2; ++uu_)
    for (int sp = 0; sp < 8; ++sp) {
        const __amdgpu_buffer_rsrc_t rs = __builtin_amdgcn_make_buffer_rsrc((void*)(ws + WS_UP + (size_t)sp * (2 * MiB)), (short)0, (int)(2 * MiB), 0x00020000);
        for (int i = 0; i < 16; ++i) {
            const int tl = tl0 + i; const size_t tok = (size_t)grp * 128 + tl;
            u32x4 r[16]; float cf[16];
#pragma unroll
            for (int ii = 0; ii < 16; ++ii) { r[ii] = bload16(rs, (unsigned)EIDX[tl * 128 + 8 * ii + g] * 128u + 16u * j); cf[ii] = DOTS[tl * 128 + 8 * ii + g]; }
            float acc[16];
#pragma unroll
            for (int k = 0; k < 16; ++k) acc[k] = 0.f;
#pragma unroll
            for (int ii = 0; ii < 16; ++ii) {
                const unsigned w[4] = {r[ii].x, r[ii].y, r[ii].z, r[ii].w};
#pragma unroll
                for (int k = 0; k < 4; ++k) { const f32x2v lo = __builtin_amdgcn_cvt_pk_f32_fp8((int)w[k], false), hi2 = __builtin_amdgcn_cvt_pk_f32_fp8((int)w[k], true);
                    acc[4 * k] += cf[ii] * lo.x; acc[4 * k + 1] += cf[ii] * lo.y; acc[4 * k + 2] += cf[ii] * hi2.x; acc[4 * k + 3] += cf[ii] * hi2.y; } }
#pragma unroll
            for (int k = 0; k < 16; ++k) { acc[k] += __builtin_bit_cast(float, DPP_I(__builtin_bit_cast(int, acc[k]), 0x128)); acc[k] += __shfl_xor(acc[k], 16); acc[k] += __shfl_xor(acc[k], 32); }
            if (g == 0 && !dry && uu_ == 1) { float* op = a.out + tok * 1024 + 128 * sp + 16 * j; const bf16* xp = (const bf16*)(ws + WS_X2B) + tok * 1024 + 128 * sp + 16 * j;
                float x2a[8], x2b[8]; unpack8(*(const u32x4*)xp, x2a); unpack8(*(const u32x4*)(xp + 8), x2b);
#pragma unroll
                for (int k = 0; k < 2; ++k) { *(f32x4*)(op + 4 * k) = (f32x4){x2a[4 * k] + acc[4 * k], x2a[4 * k + 1] + acc[4 * k + 1], x2a[4 * k + 2] + acc[4 * k + 2], x2a[4 * k + 3] + acc[4 * k + 3]};
                    *(f32x4*)(op + 8 + 4 * k) = (f32x4){x2b[4 * k] + acc[8 + 4 * k], x2b[4 * k + 1] + acc[8 + 4 * k + 1], x2b[4 * k + 2] + acc[8 + 4 * k + 2], x2b[4 * k + 3] + acc[8 + 4 * k + 3]}; } }
        }
    }
    __syncthreads();
}

DI float wave_max(float v) {
#pragma unroll
    for (int o = 1; o < 64; o <<= 1) v = fmaxf(v, __shfl_xor(v, o));
    return v; }
DI void peer_table_rows(const Args& a, int gw, int NGW, int lane, int rbeg, int rend) {
    for (int r0 = rbeg + gw * 4; r0 < rend; r0 += NGW * 4) {
        const bool dn = r0 < NEXP; const int e0 = dn ? r0 : r0 - NEXP;
        const float* srcb = (dn ? a.in[18] : a.in[19]) + (size_t)e0 * 1024;
        f32x4 v[4][2][2];
#pragma unroll
        for (int q = 0; q < 4; ++q)
#pragma unroll
            for (int j = 0; j < 2; ++j) { const int c = j * 512 + 8 * lane; v[q][j][0] = *(const f32x4*)(srcb + q * 1024 + c); v[q][j][1] = *(const f32x4*)(srcb + q * 1024 + c + 4); }
        f32x4 w[2][2];
#pragma unroll
        for (int j = 0; j < 2; ++j) { const int c = j * 512 + 8 * lane; w[j][0] = dn ? *(const f32x4*)(a.in[14] + c) : (f32x4){1.f, 1.f, 1.f, 1.f}; w[j][1] = dn ? *(const f32x4*)(a.in[14] + c + 4) : (f32x4){1.f, 1.f, 1.f, 1.f}; }
#pragma unroll
        for (int q = 0; q < 4; ++q) {
            float mx = 0.f;
#pragma unroll
            for (int j = 0; j < 2; ++j)
#pragma unroll
                for (int k = 0; k < 2; ++k) { v[q][j][k] *= w[j][k]; mx = fmaxf(mx, fmaxf(fmaxf(fabsf(v[q][j][k].x), fabsf(v[q][j][k].y)), fmaxf(fabsf(v[q][j][k].z), fabsf(v[q][j][k].w)))); }
            mx = wave_max(mx);
            const float sc = mx > 0.f ? mx * (dn ? (1.0f / 127.0f) : (1.0f / 416.0f)) : 1.0f, inv = 1.0f / sc; const int e = e0 + q;
            if (lane == 0) ((float*)(a.ws + (dn ? WS_DSC : WS_USC)))[e] = sc;
#pragma unroll
            for (int j = 0; j < 2; ++j) { const int c = j * 512 + 8 * lane; unsigned w0, w1;
                const f32x4 p = v[q][j][0] * inv, t = v[q][j][1] * inv;
                if (dn) { w0 = ((unsigned)(int)rintf(p.x) & 255u) | (((unsigned)(int)rintf(p.y) & 255u) << 8) | (((unsigned)(int)rintf(p.z) & 255u) << 16) | (((unsigned)(int)rintf(p.w) & 255u) << 24);
                          w1 = ((unsigned)(int)rintf(t.x) & 255u) | (((unsigned)(int)rintf(t.y) & 255u) << 8) | (((unsigned)(int)rintf(t.z) & 255u) << 16) | (((unsigned)(int)rintf(t.w) & 255u) << 24); }
                else { int t0 = __builtin_amdgcn_cvt_pk_fp8_f32(p.x, p.y, 0, false); t0 = __builtin_amdgcn_cvt_pk_fp8_f32(p.z, p.w, t0, true);
                       int t1 = __builtin_amdgcn_cvt_pk_fp8_f32(t.x, t.y, 0, false); t1 = __builtin_amdgcn_cvt_pk_fp8_f32(t.z, t.w, t1, true); w0 = (unsigned)t0; w1 = (unsigned)t1; }
                *(u32x2*)(a.ws + (dn ? WS_DOWN : WS_UP) + ((size_t)(c >> 7) * NEXP + e) * 128 + (c & 127)) = (u32x2){w0, w1}; }
        }
    }
}
DI void x2_quant_rows(const Args& a, int gw, int NGW, int lane) {
    for (int m0 = gw * 4; m0 < M; m0 += NGW * 4) {
        f32x4 v[4][4];
#pragma unroll
        for (int q = 0; q < 4; ++q) { const u32x2* xr = (const u32x2*)((const bf16*)(a.ws + WS_X2B) + (size_t)(m0 + q) * DM) + lane;
#pragma unroll
            for (int j = 0; j < 4; ++j) { const u32x2 w = xr[64 * j]; v[q][j] = (f32x4){__builtin_bit_cast(float, w.x << 16), __builtin_bit_cast(float, w.x & 0xffff0000u), __builtin_bit_cast(float, w.y << 16), __builtin_bit_cast(float, w.y & 0xffff0000u)}; } }
#pragma unroll
        for (int q = 0; q < 4; ++q) { float mx = 0.f;
#pragma unroll
            for (int j = 0; j < 4; ++j) mx = fmaxf(mx, fmaxf(fmaxf(fabsf(v[q][j].x), fabsf(v[q][j].y)), fmaxf(fabsf(v[q][j].z), fabsf(v[q][j].w))));
            mx = wave_max(mx);
            const float sc = mx > 0.f ? mx * (1.0f / 127.0f) : 1.0f, inv = 1.0f / sc;
            if (lane == 0) ((float*)(a.ws + WS_XSC))[m0 + q] = sc;
            unsigned* o = (unsigned*)(a.ws + WS_X2Q + (size_t)(m0 + q) * DM) + lane;
#pragma unroll
            for (int j = 0; j < 4; ++j) { const f32x4 p = v[q][j] * inv;
                o[64 * j] = ((unsigned)(int)rintf(p.x) & 255u) | (((unsigned)(int)rintf(p.y) & 255u) << 8) | (((unsigned)(int)rintf(p.z) & 255u) << 16) | (((unsigned)(int)rintf(p.w) & 255u) << 24); } }
    }
}

#define XB_TMO      128
#define XB_XCNT(j)  (256  + 64 * (j))
#define XB_XSUB(j)  (1280 + 64 * (j))
#define XB_XGEN(j)  (2304 + 64 * (j))
#define XB_TOP      3328
#define XB_TOPGEN   3392
#define XCD_BAR_WORDS 3456
#define XB_SPIN_CAP (1u << 22)
DI unsigned xb_ld(unsigned* p)              { return __hip_atomic_load(p, __ATOMIC_RELAXED, __HIP_MEMORY_SCOPE_AGENT); }
DI unsigned xb_add(unsigned* p, unsigned v) { return __hip_atomic_fetch_add(p, v, __ATOMIC_RELAXED, __HIP_MEMORY_SCOPE_AGENT); }
DI unsigned xb_xcc_id() { return (unsigned)__builtin_amdgcn_s_getreg((3 << 11) | 20) & 0xFu; }
#define XB_SPIN(cond, bar) do { unsigned _sp = 0; while (cond) { __builtin_amdgcn_s_sleep(1); \
    if ((++_sp & 255u) == 0u) { if (xb_ld(&(bar)[XB_TMO])) break; if (_sp > XB_SPIN_CAP) { atomicAdd(&(bar)[XB_TMO], 1u); break; } } } } while (0)
DI void xcd_barrier_complete(unsigned* bar, unsigned x, unsigned& nloc, unsigned& nx) {
    const unsigned G = gridDim.x * gridDim.y * gridDim.z;
    unsigned sum, cnt, mine, sp = 0u;
    for (;;) {
        sum = 0u; cnt = 0u; mine = 0u;
#pragma unroll
        for (unsigned j = 0; j < 16; ++j) { const unsigned c = xb_ld(&bar[XB_XCNT(j)]); sum += c; cnt += (c > 0u) ? 1u : 0u; mine = (j == x) ? c : mine; }
        if (sum == G) break;
        __builtin_amdgcn_s_sleep(1);
        if ((++sp & 255u) == 0u) { if (xb_ld(&bar[XB_TMO])) break; if (sp > XB_SPIN_CAP) { atomicAdd(&bar[XB_TMO], 1u); break; } }
    }
    nloc = mine > 0u ? mine : 1u; nx = cnt > 0u ? cnt : 1u;
}
DI void xcd_barrier(unsigned* bar, volatile LAS unsigned* st, bool leader) {
    asm volatile("s_waitcnt vmcnt(0)" ::: "memory");
    __syncthreads();
    if (leader) {
        const unsigned x = xb_xcc_id();
        __builtin_amdgcn_s_waitcnt(0);
        unsigned nloc = st[0], nx = st[1];
        if (nloc == 0u) { xcd_barrier_complete(bar, x, nloc, nx); st[0] = nloc; st[1] = nx; }
        const unsigned old = xb_add(&bar[XB_XSUB(x)], 1u);
        const unsigned gen = old / nloc;
        if (old + 1u == (gen + 1u) * nloc) {
            __builtin_amdgcn_fence(__ATOMIC_RELEASE, "agent");
            asm volatile("s_waitcnt vmcnt(0)" ::: "memory");
            const unsigned og = xb_add(&bar[XB_TOP], 1u);
            const unsigned tg = og / nx;
            if (og + 1u == (tg + 1u) * nx) xb_add(&bar[XB_TOPGEN], 1u);
            else XB_SPIN(xb_ld(&bar[XB_TOPGEN]) == tg, bar);
            __builtin_amdgcn_fence(__ATOMIC_ACQUIRE, "agent");
            xb_add(&bar[XB_XGEN(x)], 1u);
            asm volatile("s_waitcnt vmcnt(0)" ::: "memory");
        } else {
            XB_SPIN(xb_ld(&bar[XB_XGEN(x)]) == gen, bar);
            __builtin_amdgcn_fence(__ATOMIC_ACQUIRE, "agent");
            asm volatile("s_waitcnt vmcnt(0)" ::: "memory");
        }
    }
    __syncthreads();
}
#if GDN_CMP
__global__ void __launch_bounds__(NTHREADS, 2) gdn_v1_kernel(Args a) {
    extern __shared__ __attribute__((aligned(16))) unsigned char lds_raw2[];
    gdn_seq(a, blockIdx.x, (LAS unsigned char*)lds_raw2, threadIdx.x);
}
#endif
#if GDN_CMP
__global__ void __launch_bounds__(NTHREADS, 2) gdn_v2_dbg_kernel(Args a) {
    extern __shared__ __attribute__((aligned(16))) unsigned char lds_raw3[];
    LAS unsigned char* lds = (LAS unsigned char*)lds_raw3; unsigned char* ws = a.ws;
    const int tid = threadIdx.x, lane = tid & 63, wave = __builtin_amdgcn_readfirstlane(tid >> 6), bh = blockIdx.x;
                const int fcode = gdn_chunked(a, bh, lds, wave, lane, (bf16*)a.out);
                __syncthreads();
                { const bf16* O1 = (const bf16*)(ws + WS_OB); const bf16* O2 = (const bf16*)a.out; float sd = 0.f, sr = 0.f;
                  for (int e = tid; e < (GDN_CMP_T1 - GDN_CMP_T0) * 128; e += NTHREADS) { const size_t off = ((size_t)((bh >> 3) * SEQ + GDN_CMP_T0 + (e >> 7))) * 1024 + (bh & 7) * 128 + (e & 127);
                      const float r1 = bflo((unsigned)O1[off]), d = r1 - bflo((unsigned)O2[off]); sd += d * d; sr += r1 * r1; }
                  sd = wave_sum(sd); sr = wave_sum(sr);
                  LAS float* red = (LAS float*)lds; if (lane == 0) { red[wave] = sd; red[8 + wave] = sr; } __syncthreads();
                  float ad = 0.f, ar = 0.f; for (int w2 = 0; w2 < 8; ++w2) { ad += red[w2]; ar += red[8 + w2]; }
                  if (ad > GDN_CMP_THR * ar || fcode) { const unsigned pz = fcode == 1 ? 0x47c3u : (fcode == 2 ? 0x461cu : (fcode == 3 ? 0x447au : (fcode == 4 ? 0x42c8u : 0x4120u))); bf16* O1w = (bf16*)(ws + WS_OB); for (int e = tid; e < 64 * 128; e += NTHREADS) O1w[((size_t)((bh >> 3) * SEQ + (e >> 7))) * 1024 + (bh & 7) * 128 + (e & 127)] = (bf16)pz; }
                  __syncthreads(); }
}
#endif
DI int lane_id_opaque() { int l = (int)__builtin_amdgcn_mbcnt_hi(~0u, __builtin_amdgcn_mbcnt_lo(~0u, 0u)); asm volatile("" : "+v"(l)); return l; }
__global__ void __launch_bounds__(NTHREADS, 2) fwd_kernel(Args a_in) {
    extern __shared__ __attribute__((aligned(16))) unsigned char lds_raw[];
    LAS unsigned char* lds = (LAS unsigned char*)lds_raw;
    int wave_ = __builtin_amdgcn_readfirstlane((int)threadIdx.x >> 6); asm volatile("" : "+s"(wave_));
    const int wave = wave_;
#define LANE_ID() lane_id_opaque()
    const int G = gridDim.x, bx = blockIdx.x;
    const int gw = bx * NWAVES + wave, NGW = G * NWAVES;
#define FRESH_ARGS() const __attribute__((address_space(4))) Args* kp_ = (const __attribute__((address_space(4))) Args*)__builtin_amdgcn_kernarg_segment_ptr(); asm volatile("" : "+s"(kp_)); Args a; _Pragma("unroll") for (int i_ = 0; i_ < 20; ++i_) a.in[i_] = kp_->in[i_]; a.out = kp_->out; a.ws = kp_->ws; a.ph_lo = kp_->ph_lo; a.ph_hi = kp_->ph_hi; a.probe = kp_->probe; a.dry = kp_->dry; unsigned char* ws = a.ws; (void)ws
    volatile LAS unsigned* bar_st = (volatile LAS unsigned*)(lds + LDS_BYTES - 64);
#if MK_ONE_LAUNCH
    { const int l0 = LANE_ID(); if (wave == 0 && l0 < 2) bar_st[l0] = 0u; __syncthreads();
      if (wave == 0 && l0 == 0) (void)xb_add((unsigned*)(a_in.ws + WS_CTL) + XB_XCNT(xb_xcc_id()), 1u); }
#define GRID_BAR() do { FRESH_ARGS(); xcd_barrier((unsigned*)(a.ws + WS_CTL), bar_st, wave == 0 && LANE_ID() == 0); } while (0)
#else
#define GRID_BAR() do {} while (0)
#endif
    const int lo = a_in.ph_lo, hi = a_in.ph_hi;
#define IN(k) (lo <= (k) && (k) < hi)
#define SEAM(k) do { if (IN(k) && IN((k) + 1) && !((k) == 3 && G >= 256)) GRID_BAR(); } while (0)
    typedef pg8::bf16_t pbf;
#define REP(k) for (int rep_ = (MK_PROBE == (k)) ? 0 : 1; rep_ < 2; ++rep_)
    if (IN(0)) REP(0) { FRESH_ARGS(); phase0(a, lds, gw, NGW, wave, LANE_ID()); }
    SEAM(0);
    if (IN(1)) REP(1) {
        FRESH_ARGS();
        ab_rows(a, bx, wave, LANE_ID());
#if P1_FP8
        {
            pg8::Gemm g{(const pbf*)(ws + WS_H8), (const pbf*)(ws + WS_W8), M, P1_FP8_UPTO, 512}; pg8::StaticOrder S; S.init(M, P1_FP8_UPTO, G, bx);
            pg8::EpiIn E{ws, (pbf*)a.out + (size_t)M * DM, a.in[10], a.in[7], a.in[8], 0};
            pg8::gemm_phase<pg8::EpiIn, pg8::StaticOrder, true, true, true>(lds, g, S, E, wave);
        }
        if (P1_FP8_UPTO < NIN - 256) {
            pg8::Gemm g{(const pbf*)a.out, (const pbf*)(ws + WS_WIN) + (size_t)P1_FP8_UPTO * 1024, M, NIN - 256 - P1_FP8_UPTO, 1024}; pg8::StaticOrder S; S.init(M, NIN - 256 - P1_FP8_UPTO, G, bx);
            pg8::EpiIn E{ws, (pbf*)a.out + (size_t)M * DM, a.in[10], a.in[7], a.in[8], P1_FP8_UPTO / 256};
            pg8::gemm_phase<pg8::EpiIn, pg8::StaticOrder, true, true, false>(lds, g, S, E, wave);
        }
#else
        { pg8::Gemm g{(const pbf*)a.out, (const pbf*)(ws + WS_WIN), M, NIN - 256, 1024}; pg8::StaticOrder S; S.init(M, NIN - 256, G, bx);
          pg8::EpiIn E{ws, (pbf*)a.out + (size_t)M * DM, a.in[10], a.in[7], a.in[8], 0};
          pg8::gemm_phase<pg8::EpiIn, pg8::StaticOrder, true, true, false>(lds, g, S, E, wave); }
#endif
    }
    SEAM(1);
    if (IN(2)) REP(2) {
        __syncthreads();
        if (bx < 128 || G < 256) {
            for (int grep_ = (MK_PROBE == 20) ? 0 : 1; grep_ < 2; ++grep_)
            for (int bh = bx; bh < 128; bh += (G < 256 ? G : 128)) {
                FRESH_ARGS();
#if GDN_V1
                gdn_seq(a, bh, lds, wave * 64 + LANE_ID());
#elif GDN_CMP
                (void)bh;
#else
                gdn_chunked(a, bh, lds, wave, LANE_ID(), (bf16*)(ws + WS_OB));
#endif
            }
        }
        if (G >= 256) {
            if (bx >= 128) {
                { FRESH_ARGS(); peer_table_rows(a, (bx - 128) * 8 + wave, 1024, LANE_ID(), 0, TBL_P2_ROWS); }
                const int pm = bx - 128;
                for (int arep_ = (MK_PROBE == 22) ? 0 : 1; arep_ < 2; ++arep_)
                for (int i4 = 0; i4 < 4; ++i4) { FRESH_ARGS(); const bool dry = (rep_ == 0) || (arep_ == 0) || (a.dry != 0); attn_unit(a, pm >> 3, 4 * (pm & 7) + i4, lds + wave * 18432, wave, LANE_ID(), dry); }
                asm volatile("s_waitcnt vmcnt(0)" ::: "memory"); __syncthreads();
                if (wave == 0) { __builtin_amdgcn_fence(__ATOMIC_RELEASE, "agent"); __builtin_amdgcn_fence(__ATOMIC_ACQUIRE, "agent"); asm volatile("s_waitcnt vmcnt(0)" ::: "memory"); }
                __syncthreads();
                { FRESH_ARGS();
                  pg8::Gemm g{(const pbf*)(ws + WS_QA), (const pbf*)(ws + WS_WPA), M, 1024, 512}; pg8::RowTileOrder S{pm, 4};
                  pg8::EpiMix<false> E{(pbf*)a.out, ws + WS_MERGE, nullptr};
                  pg8::gemm_phase<pg8::EpiMix<false>, pg8::RowTileOrder, true, true>(lds, g, S, E, wave); }
            }
        }
        __syncthreads();
    }
    SEAM(2);
    SEAM(3);
    if (IN(4)) {
        FRESH_ARGS();
        pg8::Gemm g{(const pbf*)(ws + WS_OB), (const pbf*)(ws + WS_WPB), M, 1024, 1024}; pg8::StaticOrder S; S.init(M, 1024, G, bx);
        pg8::EpiMix<true> E{(pbf*)(ws + WS_MIXED), ws + WS_MERGE + 1024, (const pbf*)a.out};
        pg8::gemm_phase<pg8::EpiMix<true>, pg8::StaticOrder, true, true>(lds, g, S, E, wave);
    }
    SEAM(4);
    if (IN(5)) REP(5) {
        FRESH_ARGS();
        peer_table_rows(a, gw, NGW, LANE_ID(), TBL_P2_ROWS, 2 * NEXP);
        { pg8::Gemm g{(const pbf*)(ws + WS_MIXED), (const pbf*)(ws + WS_WOUT), M, 1024, 1024}; pg8::StaticOrder S; S.init(M, 1024, G, bx);
          pg8::EpiOut E{a.in[0], a.out, (pbf*)(ws + WS_X2B), (float*)(ws + WS_SSQ)};
          pg8::gemm_phase<pg8::EpiOut, pg8::StaticOrder, true, true>(lds, g, S, E, wave); }
    }
    SEAM(5);
    if (IN(6)) REP(6) {
        FRESH_ARGS();
        x2_quant_rows(a, gw, NGW, LANE_ID());
        { pg8::Gemm g{(const pbf*)(ws + WS_X2B), (const pbf*)(ws + WS_WQ), M, 2048, 1024}; pg8::StaticOrder S; S.init(M, 2048, G, bx);
          pg8::EpiPlain E{(pbf*)(ws + WS_QP), 2048};
          pg8::gemm_phase<pg8::EpiPlain, pg8::StaticOrder, true, true>(lds, g, S, E, wave); }
    }
    SEAM(6);
    if (IN(7)) REP(7) {
        __syncthreads();
        for (int t = bx; t < M / 128; t += G) { FRESH_ARGS(); const bool dry = (rep_ == 0) || (a.dry != 0); peer_group(a, t, lds, wave, LANE_ID(), dry); }
    }
#undef IN
#undef SEAM
}

extern "C" void kernel_launch(void* const* d_in, const int* in_sizes, int n_in, void* d_out, int out_size, void* d_ws, size_t ws_size, hipStream_t stream) {
    static int grid = 0;
    if (grid == 0) {
        if (n_in != 20 || out_size != M * DM || ws_size < WS_END) { fprintf(stderr, "kernel_launch: unexpected problem (n_in %d, out %d, ws %zu); nothing launched\n", n_in, out_size, ws_size); grid = -1; return; }
        int dev = 0, cus = 0, per_cu = 0;
        if (hipGetDevice(&dev) != hipSuccess || hipDeviceGetAttribute(&cus, hipDeviceAttributeMultiprocessorCount, dev) != hipSuccess) { grid = -1; return; }
        if (hipFuncSetAttribute((const void*)fwd_kernel, hipFuncAttributeMaxDynamicSharedMemorySize, LDS_BYTES) != hipSuccess) { fprintf(stderr, "kernel_launch: hipFuncSetAttribute failed\n"); grid = -1; return; }
        if (hipOccupancyMaxActiveBlocksPerMultiprocessor(&per_cu, (const void*)fwd_kernel, NTHREADS, LDS_BYTES) != hipSuccess || per_cu < 1) { fprintf(stderr, "kernel_launch: occupancy query says %d\n", per_cu); per_cu = 1; }
        (void)hipGetLastError();
        grid = cus;
        if (grid != 256) { fprintf(stderr, "kernel_launch: this kernel is built for a 256-CU device (got %d)\n", grid); grid = 256; }
    }
    if (grid < 0) return;
    (void)hipMemsetAsync((char*)d_ws + WS_CTL, 0, CTL_ZERO_BYTES, stream);
    Args a{};
    for (int i = 0; i < 20; ++i) a.in[i] = (const float*)d_in[i];
    a.out = (float*)d_out; a.ws = (unsigned char*)d_ws; a.probe = MK_PROBE; a.dry = 0;
#if MK_ONE_LAUNCH
    a.ph_lo = 0; a.ph_hi = N_PHASES;
    void* args[] = {&a};
    hipError_t e = hipLaunchCooperativeKernel((const void*)fwd_kernel, dim3(grid), dim3(NTHREADS), args, LDS_BYTES, stream);
    if (e != hipSuccess) fprintf(stderr, "kernel_launch: cooperative launch failed: %s (grid %d)\n", hipGetErrorString(e), grid);
#else
    for (int p = 0; p < N_PHASES; ++p) {
#if GDN_CMP
        if (p == 2) { (void)hipFuncSetAttribute((const void*)gdn_v1_kernel, hipFuncAttributeMaxDynamicSharedMemorySize, LDS_BYTES); hipLaunchKernelGGL(gdn_v1_kernel, dim3(128), dim3(NTHREADS), LDS_BYTES, stream, a);
            (void)hipFuncSetAttribute((const void*)gdn_v2_dbg_kernel, hipFuncAttributeMaxDynamicSharedMemorySize, LDS_BYTES); hipLaunchKernelGGL(gdn_v2_dbg_kernel, dim3(128), dim3(NTHREADS), LDS_BYTES, stream, a); }
#endif
        a.ph_lo = p; a.ph_hi = p + 1;
        hipLaunchKernelGGL(fwd_kernel, dim3(grid), dim3(NTHREADS), LDS_BYTES, stream, a);
    }
#endif
}
```

```cpp
#include <hip/hip_runtime.h>
#include <cstdio>
#include <cstdint>
namespace pg8 {
#define PG8_LAS __attribute__((address_space(3)))
typedef unsigned short bf16_t;
typedef short bf16x8 __attribute__((ext_vector_type(8)));
typedef float f32x4 __attribute__((ext_vector_type(4)));
typedef unsigned u32x4 __attribute__((ext_vector_type(4)));
constexpr int BM = 256, BK = 64, HALF = 128, HTB = HALF * BK * 2  , STAGE_BYTES = 8 * HTB, NXCD = 8, WGM = 8;

__host__ __device__ __forceinline__ int lds_byte(int r, int c) { const int st = (r >> 4) * 2 + (c >> 5), rr = r & 15, cc = c & 31, ob = rr * 64 + cc * 2; return st * 1024 + (ob ^ (((ob >> 9) & 1) << 5)); }
__host__ __device__ __forceinline__ void stage_rc(int b, int& R, int& C) { const int st = b / 1024, sb = b % 1024, swz = sb ^ (((sb >> 9) & 1) << 5); R = (st >> 1) * 16 + swz / 64; C = (st & 1) * 32 + (swz % 64) / 2; }
__host__ __device__ __forceinline__ int perm32(int rho) { const int n = rho >> 4, i = rho & 15; return 8 * (i >> 2) + 4 * n + (i & 3); }

struct Unit { int pm, pn; };
struct Gemm { const bf16_t* A; const bf16_t* Bt; int M, N, K; };

struct StaticOrder {
    int nM, nN, nwg, G, c;
    __host__ __device__ void init(int M, int N, int G_, int c_) { nM = M / BM; nN = N / BM; nwg = nM * nN; G = G_; c = c_; }
    __host__ __device__ bool next(int i, Unit& u) const {
        const long L = (long)i * G + c; if (L >= nwg) return false;
        int wgid = (int)L; { const int q = nwg / NXCD, r = nwg % NXCD, xcd = wgid % NXCD, off = wgid / NXCD; wgid = (xcd < r ? xcd * (q + 1) : r * (q + 1) + (xcd - r) * q) + off; }
        const int nig = WGM * nN, gid = wgid / nig, fm = gid * WGM, gsz = (nM - fm) < WGM ? (nM - fm) : WGM;
        u.pm = fm + ((wgid % nig) % gsz); u.pn = (wgid % nig) / gsz; return true;
    }
    __device__ __forceinline__ void a_ready(const Unit&) const {}
    __device__ __forceinline__ void done(const Unit&) const {}
};

__device__ __forceinline__ unsigned cvt_pk_bf16(float lo, float hi) { unsigned r; asm volatile("v_cvt_pk_bf16_f32 %0, %1, %2" : "=v"(r) : "v"(lo), "v"(hi)); return r; }
typedef float f32x2 __attribute__((ext_vector_type(2)));
__device__ __forceinline__ const char* pg8_uptr(const char* p) { const unsigned long long v = (unsigned long long)p; const unsigned lo = (unsigned)__builtin_amdgcn_readfirstlane((int)(unsigned)v), hi = (unsigned)__builtin_amdgcn_readfirstlane((int)(unsigned)(v >> 32)); return (const char*)(((unsigned long long)hi << 32) | lo); }
typedef int v8i_t __attribute__((ext_vector_type(8))); typedef int v4i_t __attribute__((ext_vector_type(4)));
template <class Epi, class Sched, bool ALIGN_EPI = false, bool SP2 = false, bool FP8 = false, bool I8 = false>
__device__ __forceinline__ void gemm_phase(PG8_LAS unsigned char* lds, const Gemm g, const Sched& S, const Epi& E, const int wid  ) {
    int lane_ = (int)__builtin_amdgcn_mbcnt_hi(~0u, __builtin_amdgcn_mbcnt_lo(~0u, 0u)); asm volatile("" : "+v"(lane_));
    const int lane = lane_, tid = wid * 64 + lane,     wr = wid >> 2, wc = wid & 3, fr = lane & 15, fq = lane >> 4;
    const int K = g.K, nt = K / BK;
    unsigned voffA[2], voffB[2];
#pragma unroll
    for (int i = 0; i < 2; ++i) { int R, C; stage_rc(tid * 16 + i * 8192, R, C); const int Rb = Epi::PERM ? ((R & ~31) + perm32(R & 31)) : R;
        voffA[i] = (unsigned)(R * K + C) * 2u; voffB[i] = (unsigned)(Rb * K + C) * 2u; }
    const size_t kstep = (size_t)(BK * 2);
    const size_t hstep = (size_t)HALF * K * 2;
    const size_t tstep = 2 * hstep;
    const unsigned ldsw = (unsigned)wid * 1024u;
    const int aoff = lds_byte(wr * 64 + fr, fq * 8), boff = lds_byte(wc * 32 + fr, fq * 8);
#define PG8_SA(b, h) (((b) * 2 + (h)) * HTB)
#define PG8_SB(b, h) ((4 + (b) * 2 + (h)) * HTB)
#define PG8_STAGE(bufoff, gbase, voff) do { const char* gb_ = pg8_uptr((const char*)(gbase)); _Pragma("unroll") for (int _i = 0; _i < 2; ++_i) \
        __builtin_amdgcn_global_load_lds((const unsigned*)(gb_ + (voff)[_i]), (PG8_LAS unsigned*)(lds + (bufoff) + ldsw + _i * 8192), 16, 0, 0); } while (0)
#define PG8_LDA(dst, b, h) do { if constexpr (FP8) { _Pragma("unroll") for (int m = 0; m < 4; ++m) dst##8[m] = PG8_CAT(*(const PG8_LAS v4i_t*)(lds + PG8_SA(b, h) + aoff + m * 2048), *(const PG8_LAS v4i_t*)(lds + PG8_SA(b, h) + aoff + m * 2048 + 1024)); } \
        else { _Pragma("unroll") for (int m = 0; m < 4; ++m) _Pragma("unroll") for (int k = 0; k < 2; ++k) dst[m][k] = *(const PG8_LAS bf16x8*)(lds + PG8_SA(b, h) + aoff + m * 2048 + k * 1024); } } while (0)
#define PG8_LDB(dst, b, h) do { if constexpr (FP8) { _Pragma("unroll") for (int n = 0; n < 2; ++n) dst##8[n] = PG8_CAT(*(const PG8_LAS v4i_t*)(lds + PG8_SB(b, h) + boff + n * 2048), *(const PG8_LAS v4i_t*)(lds + PG8_SB(b, h) + boff + n * 2048 + 1024)); } \
        else { _Pragma("unroll") for (int n = 0; n < 2; ++n) _Pragma("unroll") for (int k = 0; k < 2; ++k) dst[n][k] = *(const PG8_LAS bf16x8*)(lds + PG8_SB(b, h) + boff + n * 2048 + k * 1024); } } while (0)
#define PG8_CAT(x0, x1) __builtin_shufflevector((x0), (x1), 0, 1, 2, 3, 4, 5, 6, 7)
#define PG8_MMA(ai, bj, At, Bt) do { __builtin_amdgcn_s_setprio(1); _Pragma("unroll") for (int m = 0; m < 4; ++m) _Pragma("unroll") for (int n = 0; n < 2; ++n) { \
        if constexpr (FP8) acc[ai][bj][m][n] = __builtin_amdgcn_mfma_scale_f32_16x16x128_f8f6f4(Bt##8[n], At##8[m], acc[ai][bj][m][n], 0, 0, 0, 0x77777777, 0, 0x7f7f7f7f); \
        else if constexpr (I8) { _Pragma("unroll") for (int k = 0; k < 2; ++k) acc[ai][bj][m][n] = __builtin_bit_cast(f32x4, __builtin_amdgcn_mfma_i32_16x16x64_i8(__builtin_bit_cast(v4i_t, Bt[n][k]), __builtin_bit_cast(v4i_t, At[m][k]), __builtin_bit_cast(v4i_t, acc[ai][bj][m][n]), 0, 0, 0)); } \
        else { _Pragma("unroll") for (int k = 0; k < 2; ++k) acc[ai][bj][m][n] = __builtin_amdgcn_mfma_f32_16x16x32_bf16(Bt[n][k], At[m][k], acc[ai][bj][m][n], 0, 0, 0); } } __builtin_amdgcn_s_setprio(0); } while (0)
#define PG8_WAIT_V(n) asm volatile("s_waitcnt vmcnt(" #n ")" ::: "memory")
#define PG8_WAIT_L(n) asm volatile("s_waitcnt lgkmcnt(" #n ")" ::: "memory")
#define PG8_BAR __builtin_amdgcn_s_barrier()
#define PG8_SCHED __builtin_amdgcn_sched_barrier(0)
    Unit cur, nxt; int ui = 0;
    if (!S.next(0, cur)) return;
    f32x4 acc[2][2][4][2];
#pragma unroll
    for (int a = 0; a < 2; ++a)
#pragma unroll
        for (int b = 0; b < 2; ++b)
#pragma unroll
            for (int m = 0; m < 4; ++m)
#pragma unroll
                for (int n = 0; n < 2; ++n) acc[a][b][m][n] = (f32x4){0.f, 0.f, 0.f, 0.f};
    bf16x8 At[4][2], B0[2][2], B1[2][2];
    v8i_t At8[4], B08[2], B18[2];
    const char* cA = (const char*)g.A + (size_t)cur.pm * tstep; const char* cB = (const char*)g.Bt + (size_t)cur.pn * tstep;
    S.a_ready(cur);
    if constexpr (SP2) {
        PG8_STAGE(PG8_SB(0, 0), cB, voffB); PG8_STAGE(PG8_SB(0, 1), cB + hstep, voffB); PG8_STAGE(PG8_SA(0, 0), cA, voffA); PG8_STAGE(PG8_SA(0, 1), cA + hstep, voffA);
        if (wr == 1) PG8_BAR;
        PG8_WAIT_V(2); PG8_BAR;
        PG8_STAGE(PG8_SB(1, 0), cB + kstep, voffB); PG8_STAGE(PG8_SA(1, 0), cA + kstep, voffA); PG8_STAGE(PG8_SB(1, 1), cB + hstep + kstep, voffB);
        PG8_WAIT_V(6); PG8_BAR;
    } else {
        PG8_STAGE(PG8_SB(0, 0), cB, voffB); PG8_STAGE(PG8_SA(0, 0), cA, voffA); PG8_STAGE(PG8_SB(0, 1), cB + hstep, voffB); PG8_STAGE(PG8_SA(0, 1), cA + hstep, voffA);
        if (wr == 1) PG8_BAR;
        PG8_WAIT_V(4); PG8_BAR;
        PG8_STAGE(PG8_SB(1, 0), cB + kstep, voffB); PG8_STAGE(PG8_SA(1, 0), cA + kstep, voffA); PG8_STAGE(PG8_SB(1, 1), cB + hstep + kstep, voffB);
        PG8_WAIT_V(6); PG8_BAR;
    }
    for (;;) {
        const bool has_next = S.next(ui + 1, nxt);
        const char* nA = has_next ? (const char*)g.A + (size_t)nxt.pm * tstep : cA; const char* nB = has_next ? (const char*)g.Bt + (size_t)nxt.pn * tstep : cB;
_Pragma("unroll 1")
        for (int t = 0; t < nt; t += 2) {
            const bool last = (t == nt - 2);
            const char* a1 = cA + (size_t)(t + 1) * kstep;
            const char* a2 = last ? nA : cA + (size_t)(t + 2) * kstep; const char* b2 = last ? nB : cB + (size_t)(t + 2) * kstep;
            const char* a3 = a2 + kstep; const char* b3 = b2 + kstep;
            if (last && has_next) S.a_ready(nxt);
            if constexpr (SP2) {
            PG8_LDB(B0, 0, 0); PG8_LDB(B1, 0, 1); PG8_SCHED; PG8_LDA(At, 0, 0); PG8_STAGE(PG8_SA(1, 1), a1 + hstep, voffA);
            PG8_WAIT_V(8); PG8_WAIT_L(0); PG8_BAR; PG8_MMA(0, 0, At, B0); PG8_MMA(0, 1, At, B1); PG8_BAR; PG8_SCHED;
            PG8_LDA(At, 0, 1); PG8_STAGE(PG8_SB(0, 0), b2, voffB); PG8_STAGE(PG8_SB(0, 1), b2 + hstep, voffB); PG8_STAGE(PG8_SA(0, 0), a2, voffA);
            PG8_WAIT_V(8); PG8_WAIT_L(0); PG8_BAR; PG8_MMA(1, 0, At, B0); PG8_MMA(1, 1, At, B1); PG8_BAR; PG8_SCHED;
            PG8_LDB(B0, 1, 0); PG8_LDB(B1, 1, 1); PG8_SCHED; PG8_LDA(At, 1, 0); PG8_STAGE(PG8_SA(0, 1), a2 + hstep, voffA);
            PG8_WAIT_V(8); PG8_WAIT_L(0); PG8_BAR; PG8_MMA(0, 0, At, B0); PG8_MMA(0, 1, At, B1); PG8_BAR; PG8_SCHED;
            PG8_LDA(At, 1, 1); PG8_STAGE(PG8_SB(1, 0), b3, voffB); PG8_STAGE(PG8_SB(1, 1), b3 + hstep, voffB); PG8_STAGE(PG8_SA(1, 0), a3, voffA);
            PG8_WAIT_V(8); PG8_WAIT_L(0); PG8_BAR; PG8_MMA(1, 0, At, B0); PG8_MMA(1, 1, At, B1); PG8_BAR; PG8_SCHED;
            } else {
            PG8_LDB(B0, 0, 0); PG8_SCHED; PG8_LDA(At, 0, 0); PG8_STAGE(PG8_SA(1, 1), a1 + hstep, voffA);
            PG8_WAIT_L(8); PG8_BAR; PG8_WAIT_L(0); PG8_MMA(0, 0, At, B0); PG8_BAR; PG8_SCHED;
            PG8_LDB(B1, 0, 1); PG8_STAGE(PG8_SB(0, 0), b2, voffB);
            PG8_BAR; PG8_WAIT_L(0); PG8_MMA(0, 1, At, B1); PG8_BAR;
            PG8_LDA(At, 0, 1); PG8_STAGE(PG8_SA(0, 0), a2, voffA);
            PG8_BAR; PG8_WAIT_L(0); PG8_MMA(1, 0, At, B0); PG8_BAR; PG8_SCHED;
            PG8_STAGE(PG8_SB(0, 1), b2 + hstep, voffB);
            PG8_WAIT_V(6); PG8_BAR; PG8_MMA(1, 1, At, B1); PG8_BAR;
            PG8_LDB(B0, 1, 0); PG8_SCHED; PG8_LDA(At, 1, 0); PG8_STAGE(PG8_SA(0, 1), a2 + hstep, voffA);
            PG8_WAIT_L(8); PG8_BAR; PG8_WAIT_L(0); PG8_MMA(0, 0, At, B0); PG8_BAR; PG8_SCHED;
            PG8_LDB(B1, 1, 1); PG8_STAGE(PG8_SB(1, 0), b3, voffB);
            PG8_BAR; PG8_WAIT_L(0); PG8_MMA(0, 1, At, B1); PG8_BAR;
            PG8_LDA(At, 1, 1); PG8_STAGE(PG8_SA(1, 0), a3, voffA);
            PG8_BAR; PG8_WAIT_L(0); PG8_MMA(1, 0, At, B0); PG8_BAR; PG8_SCHED;
            PG8_STAGE(PG8_SB(1, 1), b3 + hstep, voffB);
            PG8_WAIT_V(6); PG8_BAR; PG8_MMA(1, 1, At, B1); PG8_BAR;
            }
        }
        if constexpr (ALIGN_EPI) { if (wr == 0) PG8_BAR; }
        if constexpr (!Epi::AFTER_DRAIN) { E(acc, cur, wr, wc, fr, fq); S.done(cur); }
        if (!has_next) break;
#pragma unroll
        for (int a = 0; a < 2; ++a)
#pragma unroll
            for (int b = 0; b < 2; ++b)
#pragma unroll
                for (int m = 0; m < 4; ++m)
#pragma unroll
                    for (int n = 0; n < 2; ++n) acc[a][b][m][n] = (f32x4){0.f, 0.f, 0.f, 0.f};
        cur = nxt; cA = nA; cB = nB; ++ui;
        if constexpr (ALIGN_EPI) { if (wr == 1) PG8_BAR; }
    }
    PG8_WAIT_V(0);
    if constexpr (!ALIGN_EPI) { if (wr == 0) PG8_BAR; }
    PG8_BAR;
    if constexpr (Epi::AFTER_DRAIN) { E.fused(acc, cur, wr, wc, fr, fq, lds, wid, lane); S.done(cur); }
#undef PG8_SA
#undef PG8_SB
#undef PG8_STAGE
#undef PG8_LDA
#undef PG8_LDB
#undef PG8_MMA
#undef PG8_CAT
#undef PG8_WAIT_V
#undef PG8_WAIT_L
#undef PG8_BAR
#undef PG8_SCHED
}
}

#ifndef P1_FP8
#define P1_FP8 1
#endif
#ifndef P1_FP8_UPTO
#define P1_FP8_UPTO 7680
#endif
#ifndef GDN_CMP
#define GDN_CMP 0
#define GDN_CMP_T0 0
#define GDN_CMP_T1 64
#define GDN_CMP_THR 0.01f
#endif
#ifndef GDN_NCHUNK
#define GDN_NCHUNK 32
#endif
#ifndef GDN_CHK
#define GDN_CHK 0
#endif
#ifndef GDN_TDBG
#define GDN_TDBG 0
#endif
#ifndef GDN_V1
#define GDN_V1 0
#endif
#ifndef TBL_P2_ROWS
#define TBL_P2_ROWS 20480
#endif
#ifndef MK_PROBE
#define MK_PROBE -1
#endif
#ifndef MK_ONE_LAUNCH
#define MK_ONE_LAUNCH 1
#endif
constexpr int NWAVES = 8, NTHREADS = 512, N_PHASES = 8;

constexpr int BATCH = 16, SEQ = 2048, DM = 1024, M = BATCH * SEQ;
constexpr int NIN = 7936;
constexpr float EPS = 1e-6f;
constexpr int NEXP = 16384;

constexpr size_t MiB = 1u << 20;
constexpr size_t WS_CTL = 0, CTL_ZERO_BYTES = 64 * 1024;
constexpr size_t WS_WIN = 1 * MiB;
constexpr size_t WS_WPA = 17 * MiB;
constexpr size_t WS_WPB = 18 * MiB;
constexpr size_t WS_WOUT = 20 * MiB;
constexpr size_t WS_WQ = 22 * MiB;
constexpr size_t WS_KEYS = 26 * MiB;
constexpr size_t WS_AB = 27 * MiB;
constexpr size_t WS_SSQ = 29 * MiB;
constexpr size_t WS_QA = 32 * MiB, WS_KA = 64 * MiB, WS_VA = 96 * MiB;
constexpr size_t WS_QB = 128 * MiB, WS_KB = 192 * MiB, WS_VB = 256 * MiB;
constexpr size_t WS_MERGE = 320 * MiB;
constexpr size_t WS_OB = 448 * MiB;
constexpr size_t WS_H8 = WS_OB;
constexpr size_t WS_W8 = WS_OB + 32 * MiB;
constexpr size_t WS_END = 512 * MiB;
constexpr size_t WS_MIXED = WS_KA;
constexpr size_t WS_X2B = WS_QB;
constexpr size_t WS_QP = WS_KB;
constexpr size_t WS_DOWN = WS_MERGE + 64 * MiB;
constexpr size_t WS_UP = WS_MERGE + 80 * MiB;
constexpr size_t WS_DSC = WS_MERGE + 96 * MiB;
constexpr size_t WS_USC = WS_DSC + 65536;
constexpr size_t WS_WK8 = 2 * MiB;
constexpr size_t WS_WKSC = 4 * MiB;
constexpr size_t WS_X2Q = WS_KA;
constexpr size_t WS_XSC = WS_KA + 32 * MiB;

constexpr int LDS_BYTES = 154880 + 64;

#define GAS __attribute__((address_space(1)))
#define LAS __attribute__((address_space(3)))
#define DI __device__ __forceinline__
typedef unsigned short bf16;
typedef float f32x4 __attribute__((ext_vector_type(4)));
typedef float f32x16 __attribute__((ext_vector_type(16)));
typedef short bf16x8 __attribute__((ext_vector_type(8)));
typedef unsigned u32x4 __attribute__((ext_vector_type(4)));
typedef unsigned u32x2 __attribute__((ext_vector_type(2)));
typedef float f32x2v __attribute__((ext_vector_type(2)));

DI unsigned f2bf(float f) { unsigned u = __builtin_bit_cast(unsigned, f); return (u + 0x7fffu + ((u >> 16) & 1u)) >> 16; }
DI unsigned pk2(float lo, float hi) { return f2bf(lo) | (f2bf(hi) << 16); }
DI float bflo(unsigned u) { return __builtin_bit_cast(float, u << 16); }
DI float bfhi(unsigned u) { return __builtin_bit_cast(float, u & 0xffff0000u); }
DI float wave_sum(float v) {
#pragma unroll
    for (int o = 1; o < 64; o <<= 1) v += __shfl_xor(v, o);
    return v;
}
DI float sigmoidf_(float x) { return 1.0f / (1.0f + __expf(-x)); }
DI float softplusf_(float x) { return fmaxf(x, 0.f) + log1pf(__expf(-fabsf(x))); }
DI int crow(int reg, int h) { return (reg & 3) + 8 * (reg >> 2) + 4 * h; }
DI void unpack8(const u32x4 r, float (&f)[8]) {
    f[0] = bflo(r.x); f[1] = bfhi(r.x); f[2] = bflo(r.y); f[3] = bfhi(r.y); f[4] = bflo(r.z); f[5] = bfhi(r.z); f[6] = bflo(r.w); f[7] = bfhi(r.w);
}
DI u32x4 pack8(const float (&f)[8]) { u32x4 r; r.x = pk2(f[0], f[1]); r.y = pk2(f[2], f[3]); r.z = pk2(f[4], f[5]); r.w = pk2(f[6], f[7]); return r; }
#define MFMA32(a, b, c) __builtin_amdgcn_mfma_f32_32x32x16_bf16((a), (b), (c), 0, 0, 0)
DI u32x4 bload16(__amdgpu_buffer_rsrc_t rs, unsigned voff) { return __builtin_bit_cast(u32x4, __builtin_amdgcn_raw_buffer_load_b128(rs, (int)voff, 0, 0)); }
DI u32x4 bload16s(__amdgpu_buffer_rsrc_t rs, unsigned voff, unsigned soff) { return __builtin_bit_cast(u32x4, __builtin_amdgcn_raw_buffer_load_b128(rs, (int)voff, (int)soff, 0)); }
typedef short v4i16_t __attribute__((ext_vector_type(4)));
typedef __bf16 bf16x2_t __attribute__((ext_vector_type(2)));
DI unsigned pkbf(float lo, float hi) { typedef float f32x2_t __attribute__((ext_vector_type(2))); f32x2_t v = {lo, hi}; return __builtin_bit_cast(unsigned, __builtin_convertvector(v, bf16x2_t)); }

struct Args { const float* in[20]; float* out; unsigned char* ws; int ph_lo, ph_hi, probe, dry; };

namespace pg8 {
struct EpiIn {
    static constexpr bool PERM = true, AFTER_DRAIN = false;
    unsigned char* ws; bf16_t* GATE; const float *b_merge, *a_log, *dt_bias; int pn_off;
    __device__ __forceinline__ void operator()(const f32x4 (&acc)[2][2][4][2], const Unit& u, int wr, int wc, int fr, int fq) const {
        const int pn = u.pn + pn_off, row0 = u.pm * BM + wr * 64 + fr, cloc = wc * 32 + 8 * fq;
        {
            bf16_t* base; int ldc, colt, mode;
            if (pn < 6) { const int t = pn >> 1; base = (bf16_t*)(ws + WS_QA + (size_t)t * (WS_KA - WS_QA)); ldc = 512; colt = (pn & 1) * 256; mode = 0; }
            else if (pn < 18) { const int t = (pn - 6) >> 2; base = (bf16_t*)(ws + WS_QB + (size_t)t * (WS_KB - WS_QB)); ldc = 1024; colt = ((pn - 6) & 3) * 256; mode = 0; }
            else if (pn < 22) { base = GATE; ldc = 1024; colt = (pn - 18) * 256; mode = 1; }
            else { base = (bf16_t*)(ws + WS_MERGE); ldc = 2048; colt = (pn - 22) * 256; mode = 2; }
#pragma unroll
            for (int bj = 0; bj < 2; ++bj) {
                f32x4 b0 = (f32x4){0.f, 0.f, 0.f, 0.f}, b1 = b0;
                if (mode == 2) { b0 = *(const f32x4*)(b_merge + colt + bj * HALF + cloc); b1 = *(const f32x4*)(b_merge + colt + bj * HALF + cloc + 4); }
#pragma unroll
                for (int ai = 0; ai < 2; ++ai)
#pragma unroll
                    for (int m = 0; m < 4; ++m) {
                        f32x4 v0 = acc[ai][bj][m][0], v1 = acc[ai][bj][m][1];
                        if (mode == 1) {
#pragma unroll
                            for (int e = 0; e < 4; ++e) { v0[e] = v0[e] * __builtin_amdgcn_rcpf(1.0f + __builtin_amdgcn_exp2f(-1.4426950408889634f * v0[e])); v1[e] = v1[e] * __builtin_amdgcn_rcpf(1.0f + __builtin_amdgcn_exp2f(-1.4426950408889634f * v1[e])); }
                        } else if (mode == 2) {
#pragma unroll
                            for (int e = 0; e < 4; ++e) { v0[e] = __builtin_amdgcn_rcpf(1.0f + __builtin_amdgcn_exp2f(-1.4426950408889634f * (v0[e] + b0[e]))); v1[e] = __builtin_amdgcn_rcpf(1.0f + __builtin_amdgcn_exp2f(-1.4426950408889634f * (v1[e] + b1[e]))); }
                        }
                        if (mode == 2) {
                            unsigned g0 = 0u, g1 = 0u;
                            g0 = __builtin_amdgcn_cvt_pk_u8_f32(v0[0] * 255.0f + 0.5f, 0, g0); g0 = __builtin_amdgcn_cvt_pk_u8_f32(v0[1] * 255.0f + 0.5f, 1, g0); g0 = __builtin_amdgcn_cvt_pk_u8_f32(v0[2] * 255.0f + 0.5f, 2, g0); g0 = __builtin_amdgcn_cvt_pk_u8_f32(v0[3] * 255.0f + 0.5f, 3, g0);
                            g1 = __builtin_amdgcn_cvt_pk_u8_f32(v1[0] * 255.0f + 0.5f, 0, g1); g1 = __builtin_amdgcn_cvt_pk_u8_f32(v1[1] * 255.0f + 0.5f, 1, g1); g1 = __builtin_amdgcn_cvt_pk_u8_f32(v1[2] * 255.0f + 0.5f, 2, g1); g1 = __builtin_amdgcn_cvt_pk_u8_f32(v1[3] * 255.0f + 0.5f, 3, g1);
                            *(u32x2*)((unsigned char*)base + (size_t)(row0 + ai * HALF + m * 16) * 2048 + colt + bj * HALF + cloc) = (u32x2){g0, g1};
                        } else {
                        u32x4 w; w.x = cvt_pk_bf16(v0[0], v0[1]); w.y = cvt_pk_bf16(v0[2], v0[3]); w.z = cvt_pk_bf16(v1[0], v1[1]); w.w = cvt_pk_bf16(v1[2], v1[3]);
                        *(u32x4*)(base + (size_t)(row0 + ai * HALF + m * 16) * ldc + colt + bj * HALF + cloc) = w; }
                    }
            }
        }
    }
};
template <bool SECOND> struct EpiMix {
    static constexpr bool PERM = true, AFTER_DRAIN = false;
    bf16_t* MIXED; const unsigned char* GATES; const bf16_t* PART;
    __device__ __forceinline__ void operator()(const f32x4 (&acc)[2][2][4][2], const Unit& u, int wr, int wc, int fr, int fq) const {
        const int row0 = u.pm * BM + wr * 64 + fr, col0 = u.pn * BM + wc * 32 + 8 * fq;
#pragma unroll
        for (int ai = 0; ai < 2; ++ai)
#pragma unroll
            for (int m = 0; m < 4; ++m)
#pragma unroll
                for (int bj = 0; bj < 2; ++bj) {
                    const size_t row = (size_t)(row0 + ai * HALF + m * 16); const int col = col0 + bj * HALF;
                    const u32x2 g = *(const u32x2*)(GATES + row * 2048 + col);
                    float gv[8];
#pragma unroll
                    for (int e = 0; e < 4; ++e) { gv[e] = (float)((g.x >> (8 * e)) & 255u) * (1.0f / 255.0f); gv[4 + e] = (float)((g.y >> (8 * e)) & 255u) * (1.0f / 255.0f); }
                    const f32x4 a0 = acc[ai][bj][m][0], a1 = acc[ai][bj][m][1];
                    float o[8];
#pragma unroll
                    for (int e = 0; e < 4; ++e) { o[e] = a0[e] * gv[e]; o[4 + e] = a1[e] * gv[4 + e]; }
                    bf16_t* dst = MIXED + row * 1024 + col;
                    if (SECOND) { const u32x4 p = *(const u32x4*)(PART + row * 1024 + col);
                        o[0] += __builtin_bit_cast(float, p.x << 16); o[1] += __builtin_bit_cast(float, p.x & 0xffff0000u); o[2] += __builtin_bit_cast(float, p.y << 16); o[3] += __builtin_bit_cast(float, p.y & 0xffff0000u);
                        o[4] += __builtin_bit_cast(float, p.z << 16); o[5] += __builtin_bit_cast(float, p.z & 0xffff0000u); o[6] += __builtin_bit_cast(float, p.w << 16); o[7] += __builtin_bit_cast(float, p.w & 0xffff0000u); }
                    u32x4 w; w.x = cvt_pk_bf16(o[0], o[1]); w.y = cvt_pk_bf16(o[2], o[3]); w.z = cvt_pk_bf16(o[4], o[5]); w.w = cvt_pk_bf16(o[6], o[7]);
                    *(u32x4*)dst = w;
                }
    }
};
struct EpiOut {
    static constexpr bool PERM = false, AFTER_DRAIN = false;
    const float* X; float* OUT; bf16_t* X2B; float* SSQ;
    __device__ __forceinline__ void operator()(const f32x4 (&acc)[2][2][4][2], const Unit& u, int wr, int wc, int fr, int fq) const {
        const int row0 = u.pm * BM + wr * 64 + fr, col0 = u.pn * BM + wc * 32 + 4 * fq;
#pragma unroll
        for (int ai = 0; ai < 2; ++ai)
#pragma unroll
            for (int m = 0; m < 4; ++m) {
                const size_t row = (size_t)(row0 + ai * HALF + m * 16); float ss = 0.f;
#pragma unroll
                for (int bj = 0; bj < 2; ++bj)
#pragma unroll
                    for (int n = 0; n < 2; ++n) {
                        const size_t off = row * 1024 + col0 + bj * HALF + n * 16;
                        const f32x4 o = *(const f32x4*)(X + off) + acc[ai][bj][m][n];
                        ss += (o[0] * o[0] + o[1] * o[1]) + (o[2] * o[2] + o[3] * o[3]);
                        unsigned lo = cvt_pk_bf16(o[0], o[1]), hi = cvt_pk_bf16(o[2], o[3]);
                        *(unsigned long long*)(X2B + off) = (unsigned long long)lo | ((unsigned long long)hi << 32);
                    }
                ss += __shfl_xor(ss, 16); ss += __shfl_xor(ss, 32);
                if (fq == 0) SSQ[row * 16 + u.pn * 4 + wc] = ss;
            }
    }
};
struct RowTileOrder {
    int pm, nN;
    __device__ __forceinline__ bool next(int i, Unit& u) const { if (i >= nN) return false; u.pm = pm; u.pn = i; return true; }
    __device__ __forceinline__ void a_ready(const Unit&) const {}
    __device__ __forceinline__ void done(const Unit&) const {}
};
struct EpiPlain {
    static constexpr bool PERM = true, AFTER_DRAIN = false;
    bf16_t* O; int ldc;
    __device__ __forceinline__ void operator()(const f32x4 (&acc)[2][2][4][2], const Unit& u, int wr, int wc, int fr, int fq) const {
        const int row0 = u.pm * BM + wr * 64 + fr, col0 = u.pn * BM + wc * 32 + 8 * fq;
#pragma unroll
        for (int ai = 0; ai < 2; ++ai)
#pragma unroll
            for (int m = 0; m < 4; ++m)
#pragma unroll
                for (int bj = 0; bj < 2; ++bj) {
                    const f32x4 v0 = acc[ai][bj][m][0], v1 = acc[ai][bj][m][1];
                    u32x4 w; w.x = cvt_pk_bf16(v0[0], v0[1]); w.y = cvt_pk_bf16(v0[2], v0[3]); w.z = cvt_pk_bf16(v1[0], v1[1]); w.w = cvt_pk_bf16(v1[2], v1[3]);
                    *(u32x4*)(O + (size_t)(row0 + ai * HALF + m * 16) * ldc + col0 + bj * HALF) = w;
                }
    }
};
struct EpiScore {
    static constexpr bool PERM = true, AFTER_DRAIN = false;
    bf16_t* O; const float* XSC; const float* WKSC;
    __device__ __forceinline__ void operator()(const f32x4 (&acc)[2][2][4][2], const Unit& u, int wr, int wc, int fr, int fq) const {
        const int row0 = u.pm * BM + wr * 64 + fr, col0 = u.pn * BM + wc * 32 + 8 * fq;
        f32x4 cs[2][2];
#pragma unroll
        for (int bj = 0; bj < 2; ++bj) { cs[bj][0] = *(const f32x4*)(WKSC + col0 + bj * HALF); cs[bj][1] = *(const f32x4*)(WKSC + col0 + bj * HALF + 4); }
#pragma unroll
        for (int ai = 0; ai < 2; ++ai)
#pragma unroll
            for (int m = 0; m < 4; ++m) {
                const float rs = XSC[row0 + ai * HALF + m * 16];
#pragma unroll
                for (int bj = 0; bj < 2; ++bj) {
                    const v4i_t v0 = __builtin_bit_cast(v4i_t, acc[ai][bj][m][0]), v1 = __builtin_bit_cast(v4i_t, acc[ai][bj][m][1]);
                    float o[8];
#pragma unroll
                    for (int e = 0; e < 4; ++e) { o[e] = (float)v0[e] * rs * cs[bj][0][e]; o[4 + e] = (float)v1[e] * rs * cs[bj][1][e]; }
                    u32x4 w; w.x = cvt_pk_bf16(o[0], o[1]); w.y = cvt_pk_bf16(o[2], o[3]); w.z = cvt_pk_bf16(o[4], o[5]); w.w = cvt_pk_bf16(o[6], o[7]);
                    *(u32x4*)(O + (size_t)(row0 + ai * HALF + m * 16) * 2048 + col0 + bj * HALF) = w;
                }
            }
    }
};
}

template <int MODE> DI void p0_transpose_item(const float* W, int ldw, bf16* WT, int ldk, int nblk, const float* sc, LAS float* scr, int item, int lane) {
    const int kb = item / nblk, nb = item % nblk, k0 = 64 * kb, n0 = 32 * nb;
    const int nn = n0 + (lane & 31); int src = nn; bool valid = true;
    if (MODE == 1) { if (nn < 4608) src = nn; else if (nn < 7680) src = nn + 16; else if (nn < 7696) src = nn - 7680 + 4608; else { valid = false; src = 0; } }
#pragma unroll 8
    for (int i = 0; i < 32; ++i) { const int kk = 2 * i + (lane >> 5); float v = W[(size_t)(k0 + kk) * ldw + src]; if (!valid) v = 0.f; if (MODE == 2) v *= sc[k0 + kk]; scr[kk * 33 + (lane & 31)] = v; }
    asm volatile("s_waitcnt lgkmcnt(0)" ::: "memory");
    const int c = lane & 7;
#pragma unroll
    for (int j = 0; j < 4; ++j) { const int n = (lane >> 3) + 8 * j; const LAS float* s = scr + (8 * c) * 33 + n;
        u32x4 o; o.x = pk2(s[0 * 33], s[1 * 33]); o.y = pk2(s[2 * 33], s[3 * 33]); o.z = pk2(s[4 * 33], s[5 * 33]); o.w = pk2(s[6 * 33], s[7 * 33]);
        *(u32x4*)(WT + (size_t)(n0 + n) * ldk + k0 + 8 * c) = o; }
    asm volatile("s_waitcnt lgkmcnt(0)" ::: "memory");
}
DI void p0_transpose_item_fp8(const float* W, int ldw, unsigned char* WT8, int ldk, int nblk, LAS float* scr, int item, int lane) {
    const int kb = item / nblk, nb = item % nblk, k0 = 64 * kb, n0 = 32 * nb;
    const int nn = n0 + (lane & 31); int src = nn; bool valid = true;
    { if (nn < 4608) src = nn; else if (nn < 7680) src = nn + 16; else if (nn < 7696) src = nn - 7680 + 4608; else { valid = false; src = 0; } }
#pragma unroll 8
    for (int i = 0; i < 32; ++i) { const int kk = 2 * i + (lane >> 5); float v = W[(size_t)(k0 + kk) * ldw + src]; if (!valid) v = 0.f; scr[kk * 33 + (lane & 31)] = v * 256.0f; }
    asm volatile("s_waitcnt lgkmcnt(0)" ::: "memory");
    const int c = lane & 7;
#pragma unroll
    for (int j = 0; j < 4; ++j) { const int n = (lane >> 3) + 8 * j; const LAS float* s = scr + (8 * c) * 33 + n;
        int w0 = __builtin_amdgcn_cvt_pk_fp8_f32(s[0 * 33], s[1 * 33], 0, false); w0 = __builtin_amdgcn_cvt_pk_fp8_f32(s[2 * 33], s[3 * 33], w0, true);
        int w1 = __builtin_amdgcn_cvt_pk_fp8_f32(s[4 * 33], s[5 * 33], 0, false); w1 = __builtin_amdgcn_cvt_pk_fp8_f32(s[6 * 33], s[7 * 33], w1, true);
        *(u32x2*)(WT8 + (size_t)(n0 + n) * ldk + k0 + 8 * c) = (u32x2){(unsigned)w0, (unsigned)w1}; }
    asm volatile("s_waitcnt lgkmcnt(0)" ::: "memory");
}
DI void rms_row_to_bf16(const float* xrow, const float* w, bf16* orow, int lane) {
    const f32x4* xr = (const f32x4*)xrow + lane; const f32x4* wr = (const f32x4*)w + lane;
    f32x4 v[4]; float s = 0.f;
#pragma unroll
    for (int j = 0; j < 4; ++j) { v[j] = xr[64 * j]; s += (v[j].x * v[j].x + v[j].y * v[j].y) + (v[j].z * v[j].z + v[j].w * v[j].w); }
    const float rstd = 1.0f / sqrtf(wave_sum(s) * (1.0f / DM) + EPS);
    unsigned long long* o8 = (unsigned long long*)orow + lane;
#pragma unroll
    for (int j = 0; j < 4; ++j) { const f32x4 ww = wr[64 * j]; const f32x4 o = v[j] * rstd * ww; o8[64 * j] = (unsigned long long)pk2(o.x, o.y) | ((unsigned long long)pk2(o.z, o.w) << 32); }
}

DI void wk_tile(const Args& a, int job, int lane) {
    const int r32 = lane & 31, hi = lane >> 5;
    const int blk = job >> 7, h = blk >> 1, p = blk & 1, kt = (job & 127) >> 5, jt = job & 31;
    const float* kp = (p == 0 ? a.in[16] : a.in[17]) + ((size_t)(h * 128 + kt * 32 + r32)) * 128 + 8 * hi;
    const int j = jt * 32 + r32; const float* wp = a.in[15] + (size_t)j * 2048 + h * 256 + p * 128 + 8 * hi; const float wn = a.in[14][j];
    f32x16 acc;
#pragma unroll
    for (int r = 0; r < 16; ++r) acc[r] = 0.f;
#pragma unroll
    for (int s = 0; s < 8; ++s) {
        const f32x4 k0 = *(const f32x4*)(kp + 16 * s), k1 = *(const f32x4*)(kp + 16 * s + 4), w0 = *(const f32x4*)(wp + 16 * s) * wn, w1 = *(const f32x4*)(wp + 16 * s + 4) * wn;
        u32x4 ka, wb; ka.x = pkbf(k0.x, k0.y); ka.y = pkbf(k0.z, k0.w); ka.z = pkbf(k1.x, k1.y); ka.w = pkbf(k1.z, k1.w); wb.x = pkbf(w0.x, w0.y); wb.y = pkbf(w0.z, w0.w); wb.z = pkbf(w1.x, w1.y); wb.w = pkbf(w1.z, w1.w);
        acc = MFMA32(__builtin_bit_cast(bf16x8, ka), __builtin_bit_cast(bf16x8, wb), acc); }
    bf16* dst = (bf16*)(a.ws + WS_WQ) + ((size_t)(blk * 128 + kt * 32)) * 1024 + j;
#pragma unroll
    for (int r = 0; r < 16; ++r) dst[(size_t)crow(r, hi) * 1024] = (bf16)(pkbf(acc[r], 0.f) & 0xffffu);
}
DI void phase0(const Args& a, LAS unsigned char* lds, int gw, int NGW, int wave, int lane) {
    unsigned char* ws = a.ws;
    LAS float* scr = (LAS float*)(lds + wave * 16384);
    constexpr int I_IN = 16 * (NIN / 32), I_PA = 8 * 32, I_PB = 16 * 32, I_OUT = 16 * 32, I_Q = 16 * 4 * 32;
    constexpr int NITEMS = I_IN + I_PA + I_PB + I_OUT + I_Q;
    for (int it = gw; it < NITEMS; it += NGW) {
        int r = it;
#if P1_FP8
        if (r < I_IN) { const int nb_ = r % (NIN / 32); if (nb_ >= P1_FP8_UPTO / 32) p0_transpose_item<1>(a.in[2], 7696, (bf16*)(ws + WS_WIN), 1024, NIN / 32, nullptr, scr, r, lane);
                        else p0_transpose_item_fp8(a.in[2], 7696, ws + WS_W8, 1024, NIN / 32, scr, r, lane); continue; } r -= I_IN;
#else
        if (r < I_IN) { p0_transpose_item<1>(a.in[2], 7696, (bf16*)(ws + WS_WIN), 1024, NIN / 32, nullptr, scr, r, lane); continue; } r -= I_IN;
#endif
        if (r < I_PA) { p0_transpose_item<0>(a.in[11], 1024, (bf16*)(ws + WS_WPA), 512, 32, nullptr, scr, r, lane); continue; } r -= I_PA;
        if (r < I_PB) { p0_transpose_item<0>(a.in[12], 1024, (bf16*)(ws + WS_WPB), 1024, 32, nullptr, scr, r, lane); continue; } r -= I_PB;
        if (r < I_OUT) { p0_transpose_item<0>(a.in[13], 1024, (bf16*)(ws + WS_WOUT), 1024, 32, nullptr, scr, r, lane); continue; } r -= I_OUT;
        wk_tile(a, r, lane);
    }
    { f32x4 wv[4];
#pragma unroll
      for (int j = 0; j < 4; ++j) wv[j] = ((const f32x4*)a.in[1])[lane + 64 * j];
      for (int m0 = gw * 4; m0 < M; m0 += NGW * 4) {
        f32x4 v[4][4];
#pragma unroll
        for (int q = 0; q < 4; ++q) { const f32x4* xr = (const f32x4*)(a.in[0] + (size_t)(m0 + q) * DM) + lane;
#pragma unroll
            for (int j = 0; j < 4; ++j) v[q][j] = xr[64 * j]; }
#pragma unroll
        for (int q = 0; q < 4; ++q) { float ssq = 0.f;
#pragma unroll
            for (int j = 0; j < 4; ++j) ssq += (v[q][j].x * v[q][j].x + v[q][j].y * v[q][j].y) + (v[q][j].z * v[q][j].z + v[q][j].w * v[q][j].w);
            const float rstd = 1.0f / sqrtf(wave_sum(ssq) * (1.0f / DM) + EPS);
            unsigned long long* o8 = (unsigned long long*)((bf16*)a.out + (size_t)(m0 + q) * DM) + lane;
#pragma unroll
            for (int j = 0; j < 4; ++j) { const f32x4 o = v[q][j] * rstd * wv[j]; o8[64 * j] = (unsigned long long)pkbf(o.x, o.y) | ((unsigned long long)pkbf(o.z, o.w) << 32);
#if P1_FP8
                int w8 = __builtin_amdgcn_cvt_pk_fp8_f32(o.x, o.y, 0, false); w8 = __builtin_amdgcn_cvt_pk_fp8_f32(o.z, o.w, w8, true); ((unsigned*)(ws + WS_H8 + (size_t)(m0 + q) * DM))[lane + 64 * j] = (unsigned)w8;
#endif
            } }
      } }
}


typedef float f32x4m __attribute__((ext_vector_type(4)));
DI void ab_rows(const Args& a, int bx, int wave, int lane) {
    const int fr = lane & 15, fq = lane >> 4, row0 = 128 * bx + 16 * wave;
    const bf16* Ap = (const bf16*)a.out + (size_t)(row0 + fr) * 1024 + 8 * fq;
    const bf16* Bp = (const bf16*)(a.ws + WS_WIN) + (size_t)(7680 + fr) * 1024 + 8 * fq;
    f32x4m acc = {0.f, 0.f, 0.f, 0.f};
#pragma unroll 8
    for (int s = 0; s < 32; ++s) { const bf16x8 af = *(const bf16x8*)(Ap + 32 * s), bfr = *(const bf16x8*)(Bp + 32 * s); acc = __builtin_amdgcn_mfma_f32_16x16x32_bf16(af, bfr, acc, 0, 0, 0); }
    const int hcol = fr & 7; const float al = a.in[7][hcol], db = a.in[8][hcol];
#pragma unroll
    for (int i = 0; i < 4; ++i) { float v = acc[i];
        if (fr < 8) { const float x = v + db; v = -__expf(al) * (fmaxf(x, 0.f) + log1pf(__expf(-fabsf(x)))); } else v = 1.0f / (1.0f + __expf(-v));
        ((float*)(a.ws + WS_AB))[(size_t)(row0 + 4 * fq + i) * 16 + fr] = v; }
}
DI bf16x8 pack_frag(const f32x16& x, int s) {
    u32x4 p; p.x = pg8::cvt_pk_bf16(x[8 * s + 0], x[8 * s + 1]); p.y = pg8::cvt_pk_bf16(x[8 * s + 2], x[8 * s + 3]); p.z = pg8::cvt_pk_bf16(x[8 * s + 4], x[8 * s + 5]); p.w = pg8::cvt_pk_bf16(x[8 * s + 6], x[8 * s + 7]);
    return __builtin_bit_cast(bf16x8, p);
}
DI float sumsq8(const u32x4 r) { float f[8]; unpack8(r, f); float s = 0.f;
#pragma unroll
    for (int j = 0; j < 8; ++j) s += f[j] * f[j];
    return s; }
DI void attn_unit(const Args& a, int b, int n, LAS unsigned char* wl, int head, int lane, bool dry) {
    const int r32 = lane & 31, hi = lane >> 5;
    LAS bf16* vt = (LAS bf16*)wl;
    LAS float* bias = (LAS float*)(wl + 9216);
    LAS u32x4* qfl = (LAS u32x4*)(wl + 9216 + 768);
    LAS float* rkl = (LAS float*)(wl + 9216 + 768 + 8192);
    unsigned char* ws = a.ws;
    bf16* QA = (bf16*)(ws + WS_QA); const bf16* KA = (const bf16*)(ws + WS_KA); const bf16* VA = (const bf16*)(ws + WS_VA);
    for (int i = lane; i < 192; i += 64) bias[i] = a.in[5][head * 257 + 65 + i];
    bf16* Qp = QA + ((size_t)(b * SEQ + n * 64)) * 512 + head * 64;
#pragma unroll
    for (int qh = 0; qh < 2; ++qh) {
        u32x4 raw[4]; float ss = 0.f;
#pragma unroll
        for (int s = 0; s < 4; ++s) { raw[s] = *(const u32x4*)(Qp + (size_t)(qh * 32 + r32) * 512 + 16 * s + 8 * hi); ss += sumsq8(raw[s]); }
        ss += __shfl_xor(ss, 32);
        const float rstd = 0.125f / sqrtf(ss * (1.0f / 64.0f) + EPS);
#pragma unroll
        for (int s = 0; s < 4; ++s) { float f[8]; unpack8(raw[s], f);
#pragma unroll
            for (int j = 0; j < 8; ++j) { const int d = 16 * s + 8 * hi + j; f[j] *= rstd * a.in[3][d] * a.in[4][d]; }
            qfl[(qh * 4 + s) * 64 + lane] = pack8(f); }
    }
    float mrun[2] = {-1e30f, -1e30f}, lrun[2] = {0.f, 0.f};
    f32x16 o[2][2];
#pragma unroll
    for (int d = 0; d < 2; ++d)
#pragma unroll
        for (int q = 0; q < 2; ++q)
#pragma unroll
            for (int r = 0; r < 16; ++r) o[d][q][r] = 0.f;
    const int jb0 = (n >= 8) ? 0 : 8 - n;
    u32x4 kraw[2][4], vraw[8];
    const __amdgpu_buffer_rsrc_t rsK = __builtin_amdgcn_make_buffer_rsrc((void*)(ws + WS_KA), (short)0, (int)(32 * MiB), 0x00020000), rsV = __builtin_amdgcn_make_buffer_rsrc((void*)(ws + WS_VA), (short)0, (int)(32 * MiB), 0x00020000);
    const unsigned kvo = (unsigned)(r32 * 512 + 8 * hi) * 2u, vvo = (unsigned)((lane >> 3) * 512 + (lane & 7) * 8) * 2u;
#define ATT_LOADK(jbx) do { const unsigned so_ = (unsigned)(((b * SEQ + (n + (jbx) - 8) * 64) * 512 + head * 64) * 2); \
        _Pragma("unroll") for (int kb = 0; kb < 2; ++kb) _Pragma("unroll") for (int s = 0; s < 4; ++s) kraw[kb][s] = bload16s(rsK, kvo, so_ + (unsigned)((kb * 32 * 512 + 16 * s) * 2)); } while (0)
#define ATT_LOADV(jbx) do { const unsigned so_ = (unsigned)(((b * SEQ + (n + (jbx) - 8) * 64) * 512 + head * 64) * 2); \
        _Pragma("unroll") for (int it = 0; it < 8; ++it) vraw[it] = bload16s(rsV, vvo, so_ + (unsigned)(it * 8 * 512 * 2)); } while (0)
    ATT_LOADK(jb0); ATT_LOADV(jb0);
    for (int jb = jb0; jb <= 8; ++jb) {
        asm volatile("s_waitcnt lgkmcnt(0)" ::: "memory");
#pragma unroll
        for (int it = 0; it < 8; ++it) *(LAS u32x4*)(vt + (it * 8 + (lane >> 3)) * 72 + (lane & 7) * 8) = vraw[it];
        if (jb < 8) ATT_LOADV(jb + 1);
        bf16x8 kf[2][4]; float rk[2];
#pragma unroll
        for (int kb = 0; kb < 2; ++kb) { float ss = 0.f;
#pragma unroll
            for (int s = 0; s < 4; ++s) { kf[kb][s] = __builtin_bit_cast(bf16x8, kraw[kb][s]); ss += sumsq8(kraw[kb][s]); }
            ss += __shfl_xor(ss, 32); rk[kb] = 1.0f / sqrtf(ss * (1.0f / 64.0f) + EPS); if (hi == 0) rkl[kb * 32 + r32] = rk[kb]; }
        f32x16 p[2][2];
#pragma unroll
        for (int kb = 0; kb < 2; ++kb)
#pragma unroll
            for (int qh = 0; qh < 2; ++qh) {
#pragma unroll
                for (int r = 0; r < 16; ++r) p[kb][qh][r] = 0.f;
#pragma unroll
                for (int s = 0; s < 4; ++s) p[kb][qh] = MFMA32(kf[kb][s], __builtin_bit_cast(bf16x8, qfl[(qh * 4 + s) * 64 + lane]), p[kb][qh]);
            }
        if (jb < 8) ATT_LOADK(jb + 1);
#pragma unroll
        for (int kb = 0; kb < 2; ++kb)
#pragma unroll
            for (int r = 0; r < 16; ++r) {
                const int kr = crow(r, hi); const float rs = (*(const LAS f32x4*)(rkl + kb * 32 + 8 * (r >> 2) + 4 * hi))[r & 3];
                const int j = jb * 64 + kb * 32 + kr;
#pragma unroll
                for (int qh = 0; qh < 2; ++qh) { int rel = 512 + qh * 32 + r32 - j; rel = rel < -128 ? -128 : (rel > 128 ? 128 : rel);
                    p[kb][qh][r] = p[kb][qh][r] * rs + bias[rel + 63]; }
            }
#pragma unroll
        for (int qh = 0; qh < 2; ++qh) {
            float mx = -1e30f;
#pragma unroll
            for (int kb = 0; kb < 2; ++kb)
#pragma unroll
                for (int r = 0; r < 16; ++r) mx = fmaxf(mx, p[kb][qh][r]);
            mx = fmaxf(mx, __shfl_xor(mx, 32));
            const float mnew = fmaxf(mrun[qh], mx), alpha = __expf(mrun[qh] - mnew);
            float sum = 0.f;
#pragma unroll
            for (int kb = 0; kb < 2; ++kb)
#pragma unroll
                for (int r = 0; r < 16; ++r) { const float e = __expf(p[kb][qh][r] - mnew); p[kb][qh][r] = e; sum += e; }
            sum += __shfl_xor(sum, 32);
            lrun[qh] = lrun[qh] * alpha + sum; mrun[qh] = mnew;
#pragma unroll
            for (int d = 0; d < 2; ++d)
#pragma unroll
                for (int r = 0; r < 16; ++r) o[d][qh][r] *= alpha;
        }
        asm volatile("s_waitcnt lgkmcnt(0)" ::: "memory");
#pragma unroll
        for (int kb = 0; kb < 2; ++kb)
#pragma unroll
            for (int s2 = 0; s2 < 2; ++s2) {
                bf16x8 af[2];
#pragma unroll
                for (int d = 0; d < 2; ++d) {
                    const LAS bf16* rp = vt + (kb * 32 + 16 * s2 + 4 * hi + ((lane & 15) >> 2)) * 72 + d * 32 + 16 * ((lane >> 4) & 1) + 4 * (lane & 3);
                    const v4i16_t lo = __builtin_amdgcn_ds_read_tr16_b64_v4i16((LAS v4i16_t*)rp), hi2 = __builtin_amdgcn_ds_read_tr16_b64_v4i16((LAS v4i16_t*)(rp + 8 * 72));
                    af[d] = (bf16x8){lo[0], lo[1], lo[2], lo[3], hi2[0], hi2[1], hi2[2], hi2[3]}; }
#pragma unroll
                for (int qh = 0; qh < 2; ++qh) { const bf16x8 bfq = pack_frag(p[kb][qh], s2);
#pragma unroll
                    for (int d = 0; d < 2; ++d) o[d][qh] = MFMA32(af[d], bfq, o[d][qh]); }
            }
    }
#undef ATT_LOADK
#undef ATT_LOADV
    if (!dry) {
#pragma unroll
    for (int qh = 0; qh < 2; ++qh) { const float inv = 1.0f / lrun[qh];
#pragma unroll
        for (int d = 0; d < 2; ++d)
#pragma unroll
            for (int r = 0; r < 16; ++r) Qp[(size_t)(qh * 32 + r32) * 512 + d * 32 + crow(r, hi)] = (bf16)(pkbf(o[d][qh][r] * inv, 0.f) & 0xffffu);
    }
    }
}

DI void gdn_seq(const Args& a, int bh, LAS unsigned char* lds, int tid) {
    const int b = bh >> 3, h = bh & 7;
    unsigned char* ws = a.ws;
    LAS float* qs = (LAS float*)lds; LAS float* ks = qs + 64 * 128; LAS float* vs = ks + 64 * 128; LAS float* os = vs + 64 * 128;
    LAS float* eg = os + 64 * 128; LAS float* be = eg + 64;
    const float* AB = (const float*)(ws + WS_AB);
    const bf16* GATE = (const bf16*)a.out + (size_t)M * DM;
    bf16* OB = (bf16*)(ws + WS_OB);
    const int tens = tid >> 7, rb = (tid & 127) >> 4, seg = tid & 15;
    float cw[4][8];
#pragma unroll
    for (int i = 0; i < 4; ++i)
#pragma unroll
        for (int j = 0; j < 8; ++j) cw[i][j] = (tid < 384) ? a.in[6][(size_t)i * 3072 + tens * 1024 + h * 128 + seg * 8 + j] : 0.f;
    const bf16* srcT = (const bf16*)(ws + WS_QB + (size_t)(tens > 2 ? 2 : tens) * (WS_KB - WS_QB));
    LAS float* dstT = qs + (tens > 2 ? 2 : tens) * (64 * 128);
    const int dv = tid >> 2, part = tid & 3;
    float S[32];
#pragma unroll
    for (int i = 0; i < 32; ++i) S[i] = 0.f;
    for (int n = 0; n < 32; ++n) {
        if (tid < 384) {
            float x[11][8];
#pragma unroll
            for (int i = 0; i < 11; ++i) { const int tpos = n * 64 + rb * 8 - 3 + i;
                if (tpos >= 0) { const u32x4 raw = *(const u32x4*)(srcT + ((size_t)(b * SEQ + tpos)) * 1024 + h * 128 + seg * 8); unpack8(raw, x[i]); }
                else {
#pragma unroll
                    for (int j = 0; j < 8; ++j) x[i][j] = 0.f; } }
#pragma unroll
            for (int r = 0; r < 8; ++r) { float y[8]; float ss = 0.f;
#pragma unroll
                for (int j = 0; j < 8; ++j) { float v = cw[0][j] * x[r][j] + cw[1][j] * x[r + 1][j] + cw[2][j] * x[r + 2][j] + cw[3][j] * x[r + 3][j]; v = v / (1.0f + __expf(-v)); y[j] = v; ss += v * v; }
                if (tens < 2) { ss += __shfl_xor(ss, 1); ss += __shfl_xor(ss, 2); ss += __shfl_xor(ss, 4); ss += __shfl_xor(ss, 8);
                    const float sc = (tens == 0 ? 0.08838834764831845f : 1.0f) / sqrtf(ss + EPS);
#pragma unroll
                    for (int j = 0; j < 8; ++j) y[j] *= sc; }
                LAS float* d = dstT + (rb * 8 + r) * 128 + seg * 8;
                *(LAS f32x4*)d = (f32x4){y[0], y[1], y[2], y[3]}; *(LAS f32x4*)(d + 4) = (f32x4){y[4], y[5], y[6], y[7]}; }
        } else if (tid < 448) { const int t = tid - 384; const size_t row = (size_t)(b * SEQ + n * 64 + t);
            eg[t] = __expf(AB[row * 16 + h]); be[t] = AB[row * 16 + 8 + h]; }
        __syncthreads();
        for (int t = 0; t < 64; ++t) {
            const LAS f32x4* kp = (const LAS f32x4*)(ks + t * 128 + part * 32); const LAS f32x4* qp = (const LAS f32x4*)(qs + t * 128 + part * 32);
            f32x4 kv[8]; float kS0 = 0.f, kS1 = 0.f;
#pragma unroll
            for (int i = 0; i < 8; ++i) { kv[i] = kp[i]; kS0 += kv[i].x * S[4 * i] + kv[i].y * S[4 * i + 1]; kS1 += kv[i].z * S[4 * i + 2] + kv[i].w * S[4 * i + 3]; }
            float kS = kS0 + kS1; kS += __shfl_xor(kS, 1); kS += __shfl_xor(kS, 2);
            const float e = eg[t], c = be[t] * (vs[t * 128 + dv] - e * kS);
            float o0 = 0.f, o1 = 0.f;
#pragma unroll
            for (int i = 0; i < 8; ++i) { const f32x4 qv = qp[i];
                S[4 * i] = e * S[4 * i] + kv[i].x * c; S[4 * i + 1] = e * S[4 * i + 1] + kv[i].y * c; S[4 * i + 2] = e * S[4 * i + 2] + kv[i].z * c; S[4 * i + 3] = e * S[4 * i + 3] + kv[i].w * c;
                o0 += qv.x * S[4 * i] + qv.y * S[4 * i + 1]; o1 += qv.z * S[4 * i + 2] + qv.w * S[4 * i + 3]; }
            float ov = o0 + o1; ov += __shfl_xor(ov, 1); ov += __shfl_xor(ov, 2);
            if (part == 0) os[t * 128 + dv] = ov;
        }
        __syncthreads();
#pragma unroll
        for (int it = 0; it < 2; ++it) { const int item = tid + 512 * it, row = item >> 4, sg = item & 15;
            const LAS float* op = os + row * 128 + sg * 8; const f32x4 o0 = *(const LAS f32x4*)op, o1 = *(const LAS f32x4*)(op + 4);
            float ss = (o0.x * o0.x + o0.y * o0.y) + (o0.z * o0.z + o0.w * o0.w) + (o1.x * o1.x + o1.y * o1.y) + (o1.z * o1.z + o1.w * o1.w);
            ss += __shfl_xor(ss, 1); ss += __shfl_xor(ss, 2); ss += __shfl_xor(ss, 4); ss += __shfl_xor(ss, 8);
            const float rstd = 1.0f / sqrtf(ss * (1.0f / 128.0f) + EPS);
            const size_t off = ((size_t)(b * SEQ + n * 64 + row)) * 1024 + h * 128 + sg * 8;
            float g[8]; unpack8(*(const u32x4*)(GATE + off), g);
            const f32x4 w0 = *(const f32x4*)(a.in[9] + sg * 8), w1 = *(const f32x4*)(a.in[9] + sg * 8 + 4);
            float r[8] = {o0.x * rstd * w0.x * g[0], o0.y * rstd * w0.y * g[1], o0.z * rstd * w0.z * g[2], o0.w * rstd * w0.w * g[3],
                          o1.x * rstd * w1.x * g[4], o1.y * rstd * w1.y * g[5], o1.z * rstd * w1.z * g[6], o1.w * rstd * w1.w * g[7]};
            *(u32x4*)(OB + off) = pack8(r); }
        __syncthreads();
    }
}

constexpr int G_QS = 0, G_KS = 17408, G_KTS = 34816, G_VTS = 53248, G_NB = 71680, G_ATT = 126976, G_VEC = 136192, G_OT = 137472;
constexpr int P128 = 136, P64 = 72;
DI bf16x8 pack_frag_hw(const f32x16& x, int s) { u32x4 p; p.x = pkbf(x[8 * s], x[8 * s + 1]); p.y = pkbf(x[8 * s + 2], x[8 * s + 3]); p.z = pkbf(x[8 * s + 4], x[8 * s + 5]); p.w = pkbf(x[8 * s + 6], x[8 * s + 7]); return __builtin_bit_cast(bf16x8, p); }
DI f32x16 zero16() { f32x16 z;
#pragma unroll
    for (int r = 0; r < 16; ++r) z[r] = 0.f;
    return z; }
DI f32x16 mma_tile(const LAS bf16* A, int lda, const LAS bf16* Bt, int ldb, int ksteps, f32x16 acc, int r32, int hi) {
    for (int s = 0; s < ksteps; ++s) { const bf16x8 af = *(const LAS bf16x8*)(A + r32 * lda + 16 * s + 8 * hi); const bf16x8 bf = *(const LAS bf16x8*)(Bt + r32 * ldb + 16 * s + 8 * hi); acc = MFMA32(af, bf, acc); }
    return acc; }
DI bf16x8 afrag_perm(const LAS bf16* A, int lda, int row, int kb, int hi) { const LAS bf16* p = A + row * lda + kb + 4 * hi; const u32x2 lo = *(const LAS u32x2*)p, h2 = *(const LAS u32x2*)(p + 8);
    u32x4 t; t.x = lo.x; t.y = lo.y; t.z = h2.x; t.w = h2.y; return __builtin_bit_cast(bf16x8, t); }
DI void store_T(LAS bf16* dst, int ld, const f32x16& v, int r32, int hi) {
#pragma unroll
    for (int q = 0; q < 4; ++q) { u32x2 w; w.x = pkbf(v[4 * q], v[4 * q + 1]); w.y = pkbf(v[4 * q + 2], v[4 * q + 3]); *(LAS u32x2*)(dst + r32 * ld + 8 * q + 4 * hi) = w; } }


DI float row16_sum(float x) {
    x += __builtin_bit_cast(float, __builtin_amdgcn_update_dpp(0, __builtin_bit_cast(int, x), 0x128, 0xf, 0xf, false));
    x += __builtin_bit_cast(float, __builtin_amdgcn_update_dpp(0, __builtin_bit_cast(int, x), 0x124, 0xf, 0xf, false));
    x += __builtin_bit_cast(float, __builtin_amdgcn_update_dpp(0, __builtin_bit_cast(int, x), 0x122, 0xf, 0xf, false));
    x += __builtin_bit_cast(float, __builtin_amdgcn_update_dpp(0, __builtin_bit_cast(int, x), 0x121, 0xf, 0xf, false));
    return x; }
DI float lane_read(float v, int srclane) { return __builtin_bit_cast(float, __builtin_amdgcn_ds_bpermute(srclane << 2, __builtin_bit_cast(int, v))); }
DI void store_N(LAS bf16* dst, int ld, const f32x16& v, int r32, int hi) {
#pragma unroll
    for (int q = 0; q < 4; ++q) { const unsigned w0 = pkbf(v[4 * q], v[4 * q + 1]), w1 = pkbf(v[4 * q + 2], v[4 * q + 3]); LAS bf16* p = dst + (8 * q + 4 * hi) * ld + r32;
        p[0] = (bf16)(w0 & 0xffffu); p[ld] = (bf16)(w0 >> 16); p[2 * ld] = (bf16)(w1 & 0xffffu); p[3 * ld] = (bf16)(w1 >> 16); } }
DI unsigned yp_get_(const f32x16 (&R)[4], int r, int c) { const float f = R[r >> 2][4 * (r & 3) + c]; return __builtin_bit_cast(unsigned, f); }
#define YP_GET(R, r, c) yp_get_(R, r, c)
#define YP_SET(R, r, c, v) do { const unsigned yv_ = (unsigned)(v); const float yf_ = __builtin_bit_cast(float, yv_); (R)[(r) >> 2][4 * ((r) & 3) + (c)] = yf_; } while (0)
struct GdnRaw { u32x4 ex[3]; };
DI void gdn_stage_issue(const Args& a, int b, int h, int n, int wave, int lane, GdnRaw& raw, f32x16 (&R)[4]) {
    unsigned char* ws = a.ws;
    if (wave == 4) { const size_t row = (size_t)(b * SEQ + n * 64 + lane); const float* AB = (const float*)(ws + WS_AB); R[0][0] = AB[row * 16 + h]; R[0][1] = AB[row * 16 + 8 + h]; }
    else if (wave >= 5) {
        const int tens = wave - 5, seg = lane & 15, rblk = lane >> 4;
        const bf16* src = (const bf16*)(ws + WS_QB + (size_t)tens * (WS_KB - WS_QB)) + ((size_t)(b * SEQ + n * 64 + rblk * 16)) * 1024 + h * 128 + seg * 8;
        const bool zhalo = (n == 0) && (rblk == 0);
#pragma unroll
        for (int i = 0; i < 19; ++i) { u32x4 v = *(const u32x4*)(src + (ptrdiff_t)(i - 3) * 1024); if (i < 3 && zhalo) v = (u32x4){0u, 0u, 0u, 0u};
            if (i < 16) { YP_SET(R, i, 0, v.x); YP_SET(R, i, 1, v.y); YP_SET(R, i, 2, v.z); YP_SET(R, i, 3, v.w); } else raw.ex[i - 16] = v; }
    }
}
#define RAWROW(i) ((i) < 16 ? (u32x4){YP_GET(R, (i) & 15, 0), YP_GET(R, (i) & 15, 1), YP_GET(R, (i) & 15, 2), YP_GET(R, (i) & 15, 3)} : raw.ex[((i) - 16) < 0 ? 0 : (i) - 16])
template <int HALF> DI void gdn_stage_compute(const Args& a, int h, int wave, int lane, const GdnRaw& raw, f32x16 (&R)[4]) {
    if (wave >= 5) {
        const int tens = wave - 5, seg = lane & 15;
        float cw[4][8];
#pragma unroll
        for (int i = 0; i < 4; ++i) { const float* cp = a.in[6] + (size_t)i * 3072 + tens * 1024 + h * 128 + seg * 8; const f32x4 c0 = *(const f32x4*)cp, c1 = *(const f32x4*)(cp + 4);
            cw[i][0] = c0.x; cw[i][1] = c0.y; cw[i][2] = c0.z; cw[i][3] = c0.w; cw[i][4] = c1.x; cw[i][5] = c1.y; cw[i][6] = c1.z; cw[i][7] = c1.w; }
        float x0[8], x1[8], x2[8], x3[8];
        constexpr int R0 = (HALF == 1) ? 8 : 0, R1 = (HALF == 0) ? 8 : 16;
        unpack8(RAWROW(R0), x0); unpack8(RAWROW(R0 + 1), x1); unpack8(RAWROW(R0 + 2), x2);
#pragma unroll
        for (int r = R0; r < R1; ++r) {
            unpack8(RAWROW(r + 3), x3);
            float y[8]; float ss = 0.f;
#pragma unroll
            for (int j = 0; j < 8; ++j) { float v = cw[0][j] * x0[j] + cw[1][j] * x1[j] + cw[2][j] * x2[j] + cw[3][j] * x3[j];
                v = v * __builtin_amdgcn_rcpf(1.0f + __builtin_amdgcn_exp2f(-1.4426950408889634f * v)); y[j] = v; ss += v * v; x0[j] = x1[j]; x1[j] = x2[j]; x2[j] = x3[j]; }
            if (tens < 2) { ss = row16_sum(ss);
                const float sc = (tens == 0 ? 0.08838834764831845f : 1.0f) * __builtin_amdgcn_rsqf(ss + EPS);
#pragma unroll
                for (int j = 0; j < 8; ++j) y[j] *= sc; }
            YP_SET(R, r, 0, pg8::cvt_pk_bf16(y[0], y[1])); YP_SET(R, r, 1, pg8::cvt_pk_bf16(y[2], y[3])); YP_SET(R, r, 2, pg8::cvt_pk_bf16(y[4], y[5])); YP_SET(R, r, 3, pg8::cvt_pk_bf16(y[6], y[7]));
        }
    }
}
DI unsigned perm_lo(unsigned a, unsigned b) { return (a & 0xffffu) | (b << 16); }
DI unsigned perm_hi(unsigned a, unsigned b) { return (a >> 16) | (b & 0xffff0000u); }
DI void gdn_stage_write(LAS unsigned char* lds, int wave, int lane, const f32x16 (&R)[4]) {
    if (wave == 4) {
        LAS float* vec = (LAS float*)(lds + G_VEC);
        float gc = R[0][0];
#pragma unroll
        for (int o = 1; o < 64; o <<= 1) { const float t = lane_read(gc, lane - o); if (lane >= o) gc += t; }
        const float gl = lane_read(gc, 63);
        vec[lane] = gc; vec[64 + lane] = R[0][1]; vec[128 + lane] = __expf(gc); vec[192 + lane] = __expf(gl - gc); if (lane == 0) vec[256] = __expf(gl);
    } else if (wave >= 5) {
        const int tens = wave - 5, seg = lane & 15, rblk = lane >> 4;
        if (tens < 2) { LAS bf16* dst = (LAS bf16*)(lds + (tens == 0 ? G_QS : G_KS)) + (rblk * 16) * P128 + seg * 8;
#pragma unroll
            for (int r = 0; r < 16; ++r) *(LAS u32x4*)(dst + r * P128) = (u32x4){YP_GET(R, r, 0), YP_GET(R, r, 1), YP_GET(R, r, 2), YP_GET(R, r, 3)}; }
        if (tens >= 1) { LAS bf16* dst = (LAS bf16*)(lds + (tens == 1 ? G_KTS : G_VTS)) + (seg * 8) * P64 + rblk * 16;
#pragma unroll
            for (int jp = 0; jp < 4; ++jp) {
                unsigned lo[8], hi2[8];
#pragma unroll
                for (int rp = 0; rp < 8; ++rp) { const unsigned a0 = YP_GET(R, 2 * rp, jp), a1 = YP_GET(R, 2 * rp + 1, jp); lo[rp] = perm_lo(a0, a1); hi2[rp] = perm_hi(a0, a1); }
                *(LAS u32x4*)(dst + (2 * jp) * P64) = (u32x4){lo[0], lo[1], lo[2], lo[3]}; *(LAS u32x4*)(dst + (2 * jp) * P64 + 8) = (u32x4){lo[4], lo[5], lo[6], lo[7]};
                *(LAS u32x4*)(dst + (2 * jp + 1) * P64) = (u32x4){hi2[0], hi2[1], hi2[2], hi2[3]}; *(LAS u32x4*)(dst + (2 * jp + 1) * P64 + 8) = (u32x4){hi2[4], hi2[5], hi2[6], hi2[7]};
            } }
    }
}

DI void gdn_output(const Args& a, int b, int h, int nchunk, int ltid, const LAS bf16* OT, const u32x4 (&gq)[8], bf16* OB) {
    const int sg = ltid & 15, rw = ltid >> 4;
    const f32x4 w0 = *(const f32x4*)(a.in[9] + sg * 8), w1 = *(const f32x4*)(a.in[9] + sg * 8 + 4);
    const float nw[8] = {w0.x, w0.y, w0.z, w0.w, w1.x, w1.y, w1.z, w1.w};
#pragma unroll
    for (int it = 0; it < 8; ++it) { float o[8], g8[8]; unpack8(*(const LAS u32x4*)(OT + (rw + 8 * it) * P128 + sg * 8), o);
        float ss = 0.f;
#pragma unroll
        for (int e = 0; e < 8; ++e) ss += o[e] * o[e];
        ss = row16_sum(ss);
        const float rstd = __builtin_amdgcn_rsqf(ss * (1.0f / 128.0f) + EPS);
        unpack8(gq[it], g8);
#pragma unroll
        for (int e = 0; e < 8; ++e) o[e] = o[e] * rstd * nw[e] * g8[e];
        *(u32x4*)(OB + ((size_t)(b * SEQ + nchunk * 64 + rw + 8 * it)) * 1024 + h * 128 + sg * 8) = pack8(o); }
}
DI void gdn_gate_prefetch(const Args& a, int b, int h, int nchunk, int ltid, u32x4 (&gq)[8]) {
    const bf16* GATE = (const bf16*)a.out + (size_t)M * DM; const int sg = ltid & 15, rw = ltid >> 4;
#pragma unroll
    for (int it = 0; it < 8; ++it) gq[it] = *(const u32x4*)(GATE + ((size_t)(b * SEQ + nchunk * 64 + rw + 8 * it)) * 1024 + h * 128 + sg * 8);
}
DI int gdn_chunked(const Args& a, int bh, LAS unsigned char* lds, int wave, int lane, bf16* OBdst) {
    int failcode = 0; const int ctid = wave * 64 + lane; const int cc = ctid & 63, cpart = ctid >> 6; (void)cc; (void)cpart;
    const int b = bh >> 3, h = bh & 7; const int lane0 = lane;
    unsigned char* ws = a.ws;
#define GDN_OPAQUE_LANE() int lane = lane0; asm volatile("" : "+v"(lane)); const int r32 = lane & 31, hi = lane >> 5; (void)r32; (void)hi
    LAS bf16* Qs = (LAS bf16*)(lds + G_QS); LAS bf16* Ks = (LAS bf16*)(lds + G_KS); LAS bf16* KTs = (LAS bf16*)(lds + G_KTS); LAS bf16* VTs = (LAS bf16*)(lds + G_VTS);
    LAS bf16* NB = (LAS bf16*)(lds + G_NB); LAS bf16* ATT = (LAS bf16*)(lds + G_ATT); LAS bf16* OT = (LAS bf16*)(lds + G_OT);
    LAS float* VGC = (LAS float*)(lds + G_VEC); LAS float* VBE = VGC + 64; LAS float* VEG = VGC + 128; LAS float* VDL = VGC + 192;
    constexpr int NBQ = 9216 / 2;
    f32x16 Sacc[4];
#pragma unroll
    for (int k = 0; k < 4; ++k) Sacc[k] = zero16();
    GdnRaw raw;
    gdn_stage_issue(a, b, h, 0, wave, lane0, raw, Sacc);
    gdn_stage_compute<2>(a, h, wave, lane0, raw, Sacc);
    gdn_stage_write(lds, wave, lane0, Sacc);
    if (GDN_NCHUNK > 1) gdn_stage_issue(a, b, h, 1, wave, lane0, raw, Sacc);
    __syncthreads();
    if (wave < 4) {
#pragma unroll
        for (int k = 0; k < 4; ++k) Sacc[k] = zero16(); }

    u32x4 gq[8];
    for (int n = 0; n < GDN_NCHUNK; ++n) {
        for (int pa_ = (MK_PROBE == 23) ? 0 : 1; pa_ < 2; ++pa_) {
        if (wave < 2) {
            GDN_OPAQUE_LANE();
            const int d = wave, blk = (32 * d) * P64 + 32 * d;
            {
                f32x16 acc = mma_tile(Ks + 32 * d * P128, P128, Ks + 32 * d * P128, P128, 8, zero16(), r32, hi);
                const int jj = 32 * d + r32; const float gj = VGC[jj];
#pragma unroll
                for (int q = 0; q < 4; ++q) { const int i0 = 32 * d + 8 * q + 4 * hi; const f32x4 gi = *(const LAS f32x4*)(VGC + i0), bei = *(const LAS f32x4*)(VBE + i0);
#pragma unroll
                    for (int e = 0; e < 4; ++e) acc[4 * q + e] = (i0 + e > jj) ? -bei[e] * acc[4 * q + e] * __expf(gi[e] - gj) : 0.f; }
                store_T(NB + 2 * NBQ + blk, P64, acc, r32, hi);
            }
            {
                f32x16 acc = mma_tile(Ks + 32 * d * P128, P128, Ks + 32 * d * P128, P128, 8, zero16(), r32, hi);
                const int ii = 32 * d + r32; const float gi = VGC[ii], bei = VBE[ii]; f32x16 p0;
#pragma unroll
                for (int q = 0; q < 4; ++q) { const int j0 = 32 * d + 8 * q + 4 * hi; const f32x4 gj = *(const LAS f32x4*)(VGC + j0);
#pragma unroll
                    for (int e = 0; e < 4; ++e) { const int jj = j0 + e; const float v = (ii > jj) ? -bei * acc[4 * q + e] * __expf(gi - gj[e]) : 0.f; acc[4 * q + e] = v; p0[4 * q + e] = v + ((ii == jj) ? 1.0f : 0.f); } }
                store_T(NB + blk, P64, acc, r32, hi); store_T(NB + 4 * NBQ + blk, P64, p0, r32, hi);
            }
            asm volatile("s_waitcnt lgkmcnt(0)" ::: "memory");
#pragma unroll 1
            for (int rd = 1; rd <= 5; ++rd) {
                const int qs = (rd - 1) & 1, qd = rd & 1, ps = rd & 1, pd = (rd & 1) ^ 1;
                const LAS bf16* Qn_s = NB + qs * NBQ + blk; const LAS bf16* Qt_s = NB + (2 + qs) * NBQ + blk; const LAS bf16* Pn_s = NB + (4 + ps) * NBQ + blk;
                LAS bf16* Qn_d = NB + qd * NBQ + blk; LAS bf16* Qt_d = NB + (2 + qd) * NBQ + blk; LAS bf16* Pn_d = NB + (4 + pd) * NBQ + blk;
                const bf16x8 qt0 = *(const LAS bf16x8*)(Qt_s + r32 * P64 + 8 * hi), qt1 = *(const LAS bf16x8*)(Qt_s + r32 * P64 + 16 + 8 * hi);
                const bf16x8 qn0 = *(const LAS bf16x8*)(Qn_s + r32 * P64 + 8 * hi), qn1 = *(const LAS bf16x8*)(Qn_s + r32 * P64 + 16 + 8 * hi);
                const bf16x8 pn0 = *(const LAS bf16x8*)(Pn_s + r32 * P64 + 8 * hi), pn1 = *(const LAS bf16x8*)(Pn_s + r32 * P64 + 16 + 8 * hi);
                u32x2 pv[4];
#pragma unroll
                for (int q = 0; q < 4; ++q) pv[q] = *(const LAS u32x2*)(Pn_s + r32 * P64 + 8 * q + 4 * hi);
                f32x16 a0 = zero16(), a1 = zero16(), a2 = zero16();
                if (rd <= 4) { a0 = MFMA32(qt0, qn0, a0); a1 = MFMA32(qn0, qt0, a1); }
                if (rd >= 2) a2 = MFMA32(qt0, pn0, a2);
                if (rd <= 4) { a0 = MFMA32(qt1, qn1, a0); a1 = MFMA32(qn1, qt1, a1); }
                if (rd >= 2) a2 = MFMA32(qt1, pn1, a2);
                if (rd <= 4) { store_T(Qn_d, P64, a0, r32, hi); store_T(Qt_d, P64, a1, r32, hi); }
                if (rd >= 2) {
#pragma unroll
                    for (int q = 0; q < 4; ++q) { a2[4 * q] += bflo(pv[q].x); a2[4 * q + 1] += bfhi(pv[q].x); a2[4 * q + 2] += bflo(pv[q].y); a2[4 * q + 3] += bfhi(pv[q].y); }
                    store_T(Pn_d, P64, a2, r32, hi); }
                asm volatile("s_waitcnt lgkmcnt(0)" ::: "memory");
            }
        } else if (wave == 2) {
            GDN_OPAQUE_LANE();
            f32x16 acc = mma_tile(Ks, P128, Ks + 32 * P128, P128, 8, zero16(), r32, hi);
            const int ii = 32 + r32; const float gi = VGC[ii], bei = VBE[ii];
#pragma unroll
            for (int q = 0; q < 4; ++q) { const int j0 = 8 * q + 4 * hi; const f32x4 gj = *(const LAS f32x4*)(VGC + j0);
#pragma unroll
                for (int e = 0; e < 4; ++e) acc[4 * q + e] = -bei * acc[4 * q + e] * __expf(gi - gj[e]); }
            store_T(NB + 32 * P64, P64, acc, r32, hi);
        }
        if (wave >= 2 && wave < 5) {
            GDN_OPAQUE_LANE();
            const int bi = (wave == 3) ? 0 : 1, bj = (wave == 2) ? 1 : 0;
            f32x16 acc = mma_tile(Ks + 32 * bj * P128, P128, Qs + 32 * bi * P128, P128, 8, zero16(), r32, hi);
            const int ii = 32 * bi + r32; const float gi = VGC[ii];
#pragma unroll
            for (int q = 0; q < 4; ++q) { const int j0 = 32 * bj + 8 * q + 4 * hi; const f32x4 gj = *(const LAS f32x4*)(VGC + j0);
#pragma unroll
                for (int e = 0; e < 4; ++e) acc[4 * q + e] = (ii >= j0 + e) ? acc[4 * q + e] * __expf(gi - gj[e]) : 0.f; }
            store_T(ATT + (32 * bi) * P64 + 32 * bj, P64, acc, r32, hi);
        }
        if ((wave == 2 || wave == 3) && n > 0) { GDN_OPAQUE_LANE(); gdn_output(a, b, h, n - 1, (wave - 2) * 64 + lane, OT, gq, OBdst); }
        if (pa_ == 0) __syncthreads();
        }
        if (wave >= 5 && n + 1 < GDN_NCHUNK) { GDN_OPAQUE_LANE(); gdn_stage_compute<0>(a, h, wave, lane, raw, Sacc); }
        __syncthreads();
        const LAS bf16* Tm = NB + 4 * NBQ;
        if (wave < 4) {
          for (int sc_ = (MK_PROBE == 26) ? 0 : 1; sc_ < 2; ++sc_) {
            GDN_OPAQUE_LANE();
            const int dv0 = 32 * wave;
            bf16x8 sf[8];
#pragma unroll
            for (int s = 0; s < 8; ++s) sf[s] = pack_frag_hw(Sacc[s >> 1], s & 1);
            f32x16 X[2], OQ[2];
#pragma unroll
            for (int mi = 0; mi < 2; ++mi) { X[mi] = zero16(); OQ[mi] = zero16();
#pragma unroll
                for (int s = 0; s < 8; ++s) { X[mi] = MFMA32(afrag_perm(Ks, P128, 32 * mi + r32, 16 * s, hi), sf[s], X[mi]); OQ[mi] = MFMA32(afrag_perm(Qs, P128, 32 * mi + r32, 16 * s, hi), sf[s], OQ[mi]); } }
#pragma unroll
            for (int mi = 0; mi < 2; ++mi)
#pragma unroll
                for (int q = 0; q < 4; ++q) { const int c0 = 32 * mi + 8 * q + 4 * hi; const f32x4 b4 = *(const LAS f32x4*)(VBE + c0), e4 = *(const LAS f32x4*)(VEG + c0);
                    const u32x2 vv = *(const LAS u32x2*)(VTs + (dv0 + r32) * P64 + c0); const float v4[4] = {bflo(vv.x), bfhi(vv.x), bflo(vv.y), bfhi(vv.y)};
#pragma unroll
                    for (int e = 0; e < 4; ++e) { X[mi][4 * q + e] = b4[e] * (v4[e] - e4[e] * X[mi][4 * q + e]); OQ[mi][4 * q + e] *= e4[e]; } }
            f32x16 VN[2];
            { const bf16x8 y00 = pack_frag_hw(X[0], 0), y01 = pack_frag_hw(X[0], 1), y10 = pack_frag_hw(X[1], 0), y11 = pack_frag_hw(X[1], 1);
              VN[0] = MFMA32(afrag_perm(Tm, P64, r32, 0, hi), y00, zero16()); VN[0] = MFMA32(afrag_perm(Tm, P64, r32, 16, hi), y01, VN[0]);
              const bf16x8 n00 = pack_frag_hw(VN[0], 0), n01 = pack_frag_hw(VN[0], 1);
              f32x16 Z = MFMA32(afrag_perm(NB, P64, 32 + r32, 0, hi), n00, X[1]); Z = MFMA32(afrag_perm(NB, P64, 32 + r32, 16, hi), n01, Z);
              const bf16x8 z0 = pack_frag_hw(Z, 0), z1 = pack_frag_hw(Z, 1);
              VN[1] = MFMA32(afrag_perm(Tm, P64, 32 + r32, 32, hi), z0, zero16()); VN[1] = MFMA32(afrag_perm(Tm, P64, 32 + r32, 48, hi), z1, VN[1]); (void)y10; (void)y11; }
            { const bf16x8 v00 = pack_frag_hw(VN[0], 0), v01 = pack_frag_hw(VN[0], 1), v10 = pack_frag_hw(VN[1], 0), v11 = pack_frag_hw(VN[1], 1);
              OQ[0] = MFMA32(afrag_perm(ATT, P64, r32, 0, hi), v00, OQ[0]); OQ[0] = MFMA32(afrag_perm(ATT, P64, r32, 16, hi), v01, OQ[0]);
              OQ[1] = MFMA32(afrag_perm(ATT, P64, 32 + r32, 0, hi), v00, OQ[1]); OQ[1] = MFMA32(afrag_perm(ATT, P64, 32 + r32, 16, hi), v01, OQ[1]);
              OQ[1] = MFMA32(afrag_perm(ATT, P64, 32 + r32, 32, hi), v10, OQ[1]); OQ[1] = MFMA32(afrag_perm(ATT, P64, 32 + r32, 48, hi), v11, OQ[1]); }
#pragma unroll
            for (int mi = 0; mi < 2; ++mi)
#pragma unroll
                for (int q = 0; q < 4; ++q) { const f32x4 d4 = *(const LAS f32x4*)(VDL + 32 * mi + 8 * q + 4 * hi);
#pragma unroll
                    for (int e = 0; e < 4; ++e) VN[mi][4 * q + e] *= d4[e]; }
            if (sc_ == 1) { const float egl = VGC[256];
              const bf16x8 w0 = pack_frag_hw(VN[0], 0), w1 = pack_frag_hw(VN[0], 1), w2 = pack_frag_hw(VN[1], 0), w3 = pack_frag_hw(VN[1], 1);
#pragma unroll
              for (int kb = 0; kb < 4; ++kb) {
#pragma unroll
                  for (int r = 0; r < 16; ++r) Sacc[kb][r] *= egl;
                  Sacc[kb] = MFMA32(afrag_perm(KTs, P64, 32 * kb + r32, 0, hi), w0, Sacc[kb]); Sacc[kb] = MFMA32(afrag_perm(KTs, P64, 32 * kb + r32, 16, hi), w1, Sacc[kb]);
                  Sacc[kb] = MFMA32(afrag_perm(KTs, P64, 32 * kb + r32, 32, hi), w2, Sacc[kb]); Sacc[kb] = MFMA32(afrag_perm(KTs, P64, 32 * kb + r32, 48, hi), w3, Sacc[kb]); } }
            store_N(OT + dv0, P128, OQ[0], r32, hi); store_N(OT + 32 * P128 + dv0, P128, OQ[1], r32, hi);
          }
        } else {
            GDN_OPAQUE_LANE();
            if (wave >= 5 && n + 1 < GDN_NCHUNK) gdn_stage_compute<1>(a, h, wave, lane, raw, Sacc);
        }
        __syncthreads();

        if (wave == 2 || wave == 3) { GDN_OPAQUE_LANE(); gdn_gate_prefetch(a, b, h, n, (wave - 2) * 64 + lane, gq); }
        for (int pd_ = (MK_PROBE == 25) ? 0 : 1; pd_ < 2; ++pd_) {
        if (wave >= 4 && n + 1 < GDN_NCHUNK) { GDN_OPAQUE_LANE(); gdn_stage_write(lds, wave, lane, Sacc); if (n + 2 < GDN_NCHUNK && pd_ == 1) gdn_stage_issue(a, b, h, n + 2, wave, lane, raw, Sacc); }
        if (pd_ == 0) __syncthreads();
        }
        __syncthreads();
    }
    if (wave == 2 || wave == 3) { GDN_OPAQUE_LANE(); gdn_output(a, b, h, GDN_NCHUNK - 1, (wave - 2) * 64 + lane, OT, gq, OBdst); }
    __syncthreads();
    return failcode;
}

DI unsigned sortable(float f) { const unsigned u = __builtin_bit_cast(unsigned, f); return (u & 0x80000000u) ? ~u : (u | 0x80000000u); }
DI float unsortable(unsigned k) { const unsigned u = (k & 0x80000000u) ? (k & 0x7fffffffu) : ~k; return __builtin_bit_cast(float, u); }
#define CE_DESC(x, y) do { const unsigned _a = (x), _b = (y); (x) = _a > _b ? _a : _b; (y) = _a > _b ? _b : _a; } while (0)
#define CE_ASC(x, y) do { const unsigned _a = (x), _b = (y); (x) = _a > _b ? _b : _a; (y) = _a > _b ? _a : _b; } while (0)
DI void sort16_desc(unsigned (&v)[16]) { CE_DESC(v[0], v[1]); CE_DESC(v[2], v[3]); CE_DESC(v[0], v[2]); CE_DESC(v[1], v[3]); CE_DESC(v[1], v[2]); CE_DESC(v[4], v[5]); CE_DESC(v[6], v[7]); CE_DESC(v[4], v[6]); CE_DESC(v[5], v[7]); CE_DESC(v[5], v[6]); CE_DESC(v[0], v[4]); CE_DESC(v[2], v[6]); CE_DESC(v[2], v[4]); CE_DESC(v[1], v[5]); CE_DESC(v[3], v[7]); CE_DESC(v[3], v[5]); CE_DESC(v[1], v[2]); CE_DESC(v[3], v[4]); CE_DESC(v[5], v[6]); CE_DESC(v[8], v[9]); CE_DESC(v[10], v[11]); CE_DESC(v[8], v[10]); CE_DESC(v[9], v[11]); CE_DESC(v[9], v[10]); CE_DESC(v[12], v[13]); CE_DESC(v[14], v[15]); CE_DESC(v[12], v[14]); CE_DESC(v[13], v[15]); CE_DESC(v[13], v[14]); CE_DESC(v[8], v[12]); CE_DESC(v[10], v[14]); CE_DESC(v[10], v[12]); CE_DESC(v[9], v[13]); CE_DESC(v[11], v[15]); CE_DESC(v[11], v[13]); CE_DESC(v[9], v[10]); CE_DESC(v[11], v[12]); CE_DESC(v[13], v[14]); CE_DESC(v[0], v[8]); CE_DESC(v[4], v[12]); CE_DESC(v[4], v[8]); CE_DESC(v[2], v[10]); CE_DESC(v[6], v[14]); CE_DESC(v[6], v[10]); CE_DESC(v[2], v[4]); CE_DESC(v[6], v[8]); CE_DESC(v[10], v[12]); CE_DESC(v[1], v[9]); CE_DESC(v[5], v[13]); CE_DESC(v[5], v[9]); CE_DESC(v[3], v[11]); CE_DESC(v[7], v[15]); CE_DESC(v[7], v[11]); CE_DESC(v[3], v[5]); CE_DESC(v[7], v[9]); CE_DESC(v[11], v[13]); CE_DESC(v[1], v[2]); CE_DESC(v[3], v[4]); CE_DESC(v[5], v[6]); CE_DESC(v[7], v[8]); CE_DESC(v[9], v[10]); CE_DESC(v[11], v[12]); CE_DESC(v[13], v[14]); }
DI void merge8x8_desc(unsigned (&v)[16]) { CE_DESC(v[0], v[8]); CE_DESC(v[4], v[12]); CE_DESC(v[4], v[8]); CE_DESC(v[2], v[10]); CE_DESC(v[6], v[14]); CE_DESC(v[6], v[10]); CE_DESC(v[2], v[4]); CE_DESC(v[6], v[8]); CE_DESC(v[10], v[12]); CE_DESC(v[1], v[9]); CE_DESC(v[5], v[13]); CE_DESC(v[5], v[9]); CE_DESC(v[3], v[11]); CE_DESC(v[7], v[15]); CE_DESC(v[7], v[11]); CE_DESC(v[3], v[5]); CE_DESC(v[7], v[9]); CE_DESC(v[11], v[13]); CE_DESC(v[1], v[2]); CE_DESC(v[3], v[4]); CE_DESC(v[5], v[6]); CE_DESC(v[7], v[8]); CE_DESC(v[9], v[10]); CE_DESC(v[11], v[12]); CE_DESC(v[13], v[14]); }
DI void bitonic_merge16_desc(unsigned (&v)[16]) {
#pragma unroll
    for (int j = 8; j > 0; j >>= 1)
#pragma unroll
        for (int i = 0; i < 16; ++i) { const int l = i ^ j; if (l > i) CE_DESC(v[i], v[l]); }
}
DI void merge_top16(unsigned (&x)[16], const unsigned (&y)[16]) {
#pragma unroll
    for (int i = 0; i < 16; ++i) x[i] = x[i] > y[15 - i] ? x[i] : y[15 - i];
    bitonic_merge16_desc(x);
}
DI void merge_top16_2(unsigned (&x)[16], unsigned y0, unsigned y1) { CE_DESC(x[0], y0); CE_DESC(x[8], y0); CE_DESC(x[4], x[8]); CE_DESC(x[12], y0); CE_DESC(x[6], x[10]); CE_DESC(x[2], x[4]); CE_DESC(x[6], x[8]); CE_DESC(x[10], x[12]); CE_DESC(x[14], y0); CE_DESC(x[1], y1); CE_DESC(x[9], y1); CE_DESC(x[5], x[9]); CE_DESC(x[13], y1); CE_DESC(x[7], x[11]); CE_DESC(x[3], x[5]); CE_DESC(x[7], x[9]); CE_DESC(x[11], x[13]); x[15] = x[15] > y1 ? x[15] : y1; CE_DESC(x[1], x[2]); CE_DESC(x[3], x[4]); CE_DESC(x[5], x[6]); CE_DESC(x[7], x[8]); CE_DESC(x[9], x[10]); CE_DESC(x[11], x[12]); CE_DESC(x[13], x[14]); x[15] = x[15] > y0 ? x[15] : y0;  }
DI void top16_of_64(const unsigned (&x)[64], unsigned (&out)[16]) {
    unsigned g[4][16];
#pragma unroll
    for (int q = 0; q < 4; ++q) {
#pragma unroll
        for (int i = 0; i < 16; ++i) g[q][i] = x[16 * q + i];
        sort16_desc(g[q]); }
    merge_top16(g[0], g[1]); merge_top16(g[2], g[3]); merge_top16(g[0], g[2]);
#pragma unroll
    for (int i = 0; i < 16; ++i) out[i] = g[0][i];
}
DI float gelu_exact(float x) { return 0.5f * x * (1.0f + erff(x * 0.7071067811865476f)); }

DI void route_scores_issue(const unsigned char* ws, int tile, int p, int head, int lane, LAS unsigned char* sbuf) {
    const char* gp = (const char*)(ws + WS_QP) + ((size_t)(tile * 32 + (lane & 31)) * 2048 + head * 256 + p * 128 + 64 * (lane >> 5)) * 2;
#pragma unroll
    for (int c8 = 0; c8 < 8; ++c8) __builtin_amdgcn_global_load_lds((const unsigned*)(gp + 16 * c8), (LAS unsigned*)(sbuf + c8 * 1024), 16, 0, 0);
}
DI void peer_route_tile(const Args& a, int tile, int q4, LAS unsigned char* lds, int wave, int lane_in) {
    int lane = lane_in; asm volatile("" : "+v"(lane));
    const int r32 = lane & 31, hi = lane >> 5, head = wave;
    unsigned char* ws = a.ws;
    LAS unsigned short* EIDX = (LAS unsigned short*)lds;
    LAS unsigned short* GATEH = (LAS unsigned short*)(lds + 32768);
    LAS unsigned char* scr = lds + 65536 + wave * 2048;
    LAS unsigned char* sbuf = lds + 81920 + wave * 8192;
    const float* SSQ = (const float*)(ws + WS_SSQ);
    const int token = tile * 32 + r32;
    float rstd;
    { const f32x4* sp = (const f32x4*)(SSQ + (size_t)token * 16); const f32x4 s0 = sp[0], s1 = sp[1], s2 = sp[2], s3 = sp[3];
      const float ssq = ((s0.x + s0.y) + (s0.z + s0.w)) + ((s1.x + s1.y) + (s1.z + s1.w)) + ((s2.x + s2.y) + (s2.z + s2.w)) + ((s3.x + s3.y) + (s3.z + s3.w));
      rstd = 1.0f / sqrtf(ssq * (1.0f / DM) + EPS); }
    unsigned top[2][16];
#pragma unroll
    for (int p = 0; p < 2; ++p) {
        unsigned key[64];
        u32x4 raw[8];
        asm volatile("s_waitcnt vmcnt(0)" ::: "memory");
#pragma unroll
        for (int c8 = 0; c8 < 8; ++c8) raw[c8] = *(const LAS u32x4*)(sbuf + c8 * 1024 + lane * 16);
        asm volatile("s_waitcnt lgkmcnt(0)" ::: "memory");
        if (!(q4 == 3 && p == 1)) route_scores_issue(ws, p == 0 ? tile : tile + 1, p ^ 1, head, lane, sbuf);
#pragma unroll
        for (int c8 = 0; c8 < 8; ++c8) { float f[8]; unpack8(raw[c8], f);
#pragma unroll
            for (int e = 0; e < 8; ++e) key[8 * c8 + e] = (sortable(f[e]) & ~127u) | (unsigned)(127 - (64 * hi + 8 * c8 + e)); }
        unsigned t16[16], o16[16];
        top16_of_64(key, t16);
#pragma unroll
        for (int i = 0; i < 16; ++i) o16[i] = (unsigned)__shfl_xor((int)t16[i], 32);
        merge_top16(t16, o16);
#pragma unroll
        for (int i = 0; i < 16; ++i) top[p][i] = t16[i];
    }
    unsigned tc[16];
    {
        float A[16], B[16];
#pragma unroll
        for (int i = 0; i < 16; ++i) { A[i] = unsortable(top[0][i] & ~127u); B[i] = unsortable(top[1][i] & ~127u); }
#define CKEY(aa, bb) ((sortable(A[aa] + B[bb]) & ~255u) | (unsigned)(255 - ((aa) * 16 + (bb))))
        unsigned G1[16], G2[16];
#pragma unroll
        for (int b = 0; b < 16; ++b) tc[b] = CKEY(0, b);
#pragma unroll
        for (int b = 0; b < 8; ++b) { G1[b] = CKEY(1, b); G1[8 + b] = CKEY(8 + b, 0); }
        merge8x8_desc(G1);
        G2[0] = CKEY(2, 0); G2[1] = CKEY(2, 1); G2[2] = CKEY(2, 2); G2[3] = CKEY(2, 3); G2[4] = CKEY(2, 4); G2[5] = CKEY(3, 0); G2[6] = CKEY(3, 1); G2[7] = CKEY(3, 2); G2[8] = CKEY(3, 3);
        G2[9] = CKEY(4, 0); G2[10] = CKEY(4, 1); G2[11] = CKEY(4, 2); G2[12] = CKEY(5, 0); G2[13] = CKEY(5, 1); G2[14] = CKEY(6, 0); G2[15] = CKEY(6, 1);
        sort16_desc(G2);
        merge_top16_2(G2, CKEY(7, 0), CKEY(7, 1));
        merge_top16(tc, G1); merge_top16(tc, G2);
#undef CKEY
    }
    float gt[16];
    { float sv[16]; float sum = 0.f;
#pragma unroll
      for (int i = 0; i < 16; ++i) sv[i] = unsortable(tc[i] & ~255u) * rstd;
#pragma unroll
      for (int i = 0; i < 16; ++i) { gt[i] = __expf(sv[i] - sv[0]); sum += gt[i]; }
      const float inv = 1.0f / sum;
#pragma unroll
      for (int i = 0; i < 16; ++i) gt[i] *= inv; }
    { LAS unsigned* sw = (LAS unsigned*)(scr + lane * 32);
#pragma unroll
      for (int p = 0; p < 2; ++p)
#pragma unroll
          for (int q = 0; q < 4; ++q) sw[p * 4 + q] = (~top[p][4 * q] & 127u) | ((~top[p][4 * q + 1] & 127u) << 8) | ((~top[p][4 * q + 2] & 127u) << 16) | ((~top[p][4 * q + 3] & 127u) << 24);
      asm volatile("s_waitcnt lgkmcnt(0)" ::: "memory");
#pragma unroll
      for (int i = 0; i < 16; ++i) { const unsigned pos = ~tc[i] & 255u; const unsigned i1 = scr[lane * 32 + (pos >> 4)], i2 = scr[lane * 32 + 16 + (pos & 15u)];
          if (hi == 0) { EIDX[(q4 * 32 + r32) * 128 + head * 16 + i] = (unsigned short)(i1 * 128u + i2); GATEH[(q4 * 32 + r32) * 128 + head * 16 + i] = (unsigned short)f2bf(gt[i]); } }
    }
    asm volatile("s_waitcnt lgkmcnt(0)" ::: "memory");
}

DI float dot2bf(unsigned w, unsigned x, float acc) { return __builtin_amdgcn_fdot2_f32_bf16(__builtin_bit_cast(bf16x2_t, w), __builtin_bit_cast(bf16x2_t, x), acc, false); }
#define DPP_I(x, ctrl) __builtin_amdgcn_update_dpp(0, (x), (ctrl), 0xf, 0xf, false)
DI void peer_group(const Args& a, int grp, LAS unsigned char* lds, int wave, int lane, bool dry) {
    unsigned char* ws = a.ws;
    LAS unsigned short* EIDX = (LAS unsigned short*)lds;
    LAS unsigned short* GATEH = (LAS unsigned short*)(lds + 32768);
    LAS int* DOTI = (LAS int*)(lds + 65536);
    LAS float* DOTS = (LAS float*)(lds + 65536);
    const float* SSQ = (const float*)(ws + WS_SSQ);
    for (int rr_ = (MK_PROBE == 70) ? 0 : 1; rr_ < 2; ++rr_)
    { if (rr_ == ((MK_PROBE == 70) ? 0 : 1)) {} route_scores_issue(ws, grp * 4, 0, wave, lane, lds + 81920 + wave * 8192);
    for (int q4 = 0; q4 < 4; ++q4) peer_route_tile(a, grp * 4 + q4, q4, lds, wave, lane); }
    __syncthreads();
    const int tl0 = wave * 16, g = lane >> 3, j = lane & 7;
    for (int dd_ = (MK_PROBE == 71) ? 0 : 1; dd_ < 2; ++dd_) {
#pragma unroll
    for (int i = 0; i < 8; ++i) *(LAS u32x4*)(DOTI + tl0 * 128 + i * 256 + lane * 4) = (u32x4){0u, 0u, 0u, 0u};
    asm volatile("s_waitcnt lgkmcnt(0)" ::: "memory");
    for (int sp = 0; sp < 8; ++sp) {
        const __amdgpu_buffer_rsrc_t rs = __builtin_amdgcn_make_buffer_rsrc((void*)(ws + WS_DOWN + (size_t)sp * (2 * MiB)), (short)0, (int)(2 * MiB), 0x00020000);
        for (int i = 0; i < 16; ++i) {
            const int tl = tl0 + i; const size_t tok = (size_t)grp * 128 + tl;
            const u32x4 xq = *(const u32x4*)(ws + WS_X2Q + tok * 1024 + 128 * sp + 16 * j);
            u32x4 r[16];
#pragma unroll
            for (int ii = 0; ii < 16; ++ii) r[ii] = bload16(rs, (unsigned)EIDX[tl * 128 + 8 * ii + g] * 128u + 16u * j);
            int part0 = 0, part1 = 0;
#pragma unroll
            for (int ii = 0; ii < 16; ++ii) {
                int p = __builtin_amdgcn_sdot4((int)r[ii].x, (int)xq.x, 0, false); p = __builtin_amdgcn_sdot4((int)r[ii].y, (int)xq.y, p, false);
                p = __builtin_amdgcn_sdot4((int)r[ii].z, (int)xq.z, p, false); p = __builtin_amdgcn_sdot4((int)r[ii].w, (int)xq.w, p, false);
                p += DPP_I(p, 0xB1); p += DPP_I(p, 0x4E); p += DPP_I(p, 0x141);
                if (ii < 8) part0 += ((ii & 7) == j) ? p : 0; else part1 += ((ii & 7) == j) ? p : 0;
            }
            LAS int* dp = DOTI + tl * 128 + 8 * j + g;
            dp[0] += part0; dp[64] += part1;
        }
    }
    }
    asm volatile("s_waitcnt lgkmcnt(0)" ::: "memory");
    for (int i = 0; i < 16; ++i) {
        const int tl = tl0 + i; const size_t tok = (size_t)grp * 128 + tl;
        const float rstd_t = 1.0f / sqrtf(wave_sum(lane < 16 ? SSQ[tok * 16 + lane] : 0.f) * (1.0f / DM) + EPS) * ((const float*)(ws + WS_XSC))[tok];
#pragma unroll
        for (int q = 0; q < 2; ++q) { const int sl = tl * 128 + 64 * q + lane; const unsigned e = EIDX[sl];
            const float d = (float)DOTI[sl] * ((const float*)(ws + WS_DSC))[e] * rstd_t;
            DOTS[sl] = bflo((unsigned)GATEH[sl]) * gelu_exact(d) * ((const float*)(ws + WS_USC))[e]; }
    }
    asm volatile("s_waitcnt lgkmcnt(0)" ::: "memory");
    for (int uu_ = (MK_PROBE == 72) ? 0 : 1; uu_ < 2; ++uu_)
    for (int sp = 0; sp < 8; ++sp) {
        const __amdgpu_buffer_rsrc_t rs = __builtin_amdgcn_make_buffer_rsrc((void*)(ws + WS_UP + (size_t)sp * (2 * MiB)), (short)0, (int)(2 * MiB), 0x00020000);
        for (int i = 0; i < 16; ++i) {
            const int tl = tl0 + i; const size_t tok = (size_t)grp * 128 + tl;
            u32x4 r[16]; float cf[16];
#pragma unroll
            for (int ii = 0; ii < 16; ++ii) { r[ii] = bload16(rs, (unsigned)EIDX[tl * 128 + 8 * ii + g] * 128u + 16u * j); cf[ii] = DOTS[tl * 128 + 8 * ii + g]; }
            float acc[16];
#pragma unroll
            for (int k = 0; k < 16; ++k) acc[k] = 0.f;
#pragma unroll
            for (int ii = 0; ii < 16; ++ii) {
                const unsigned w[4] = {r[ii].x, r[ii].y, r[ii].z, r[ii].w};
#pragma unroll
                for (int k = 0; k < 4; ++k) { const f32x2v lo = __builtin_amdgcn_cvt_pk_f32_fp8((int)w[k], false), hi2 = __builtin_amdgcn_cvt_pk_f32_fp8((int)w[k], true);
                    acc[4 * k] += cf[ii] * lo.x; acc[4 * k + 1] += cf[ii] * lo.y; acc[4 * k + 2] += cf[ii] * hi2.x; acc[4 * k + 3] += cf[ii] * hi2.y; } }
#pragma unroll
            for (int k = 0; k < 16; ++k) { acc[k] += __builtin_bit_cast(float, DPP_I(__builtin_bit_cast(int, acc[k]), 0x128)); acc[k] += __shfl_xor(acc[k], 16); acc[k] += __shfl_xor(acc[k], 32); }
            if (g == 0 && !dry && uu_ == 1) { float* op = a.out + tok * 1024 + 128 * sp + 16 * j; const bf16* xp = (const bf16*)(ws + WS_X2B) + tok * 1024 + 128 * sp + 16 * j;
                float x2a[8], x2b[8]; unpack8(*(const u32x4*)xp, x2a); unpack8(*(const u32x4*)(xp + 8), x2b);
#pragma unroll
                for (int k = 0; k < 2; ++k) { *(f32x4*)(op + 4 * k) = (f32x4){x2a[4 * k] + acc[4 * k], x2a[4 * k + 1] + acc[4 * k + 1], x2a[4 * k + 2] + acc[4 * k + 2], x2a[4 * k + 3] + acc[4 * k + 3]};
                    *(f32x4*)(op + 8 + 4 * k) = (f32x4){x2b[4 * k] + acc[8 + 4 * k], x2b[4 * k + 1] + acc[8 + 4 * k + 1], x2b[4 * k + 2] + acc[8 + 4 * k + 2], x2b[4 * k + 3] + acc[8 + 4 * k + 3]}; } }
        }
    }
    __syncthreads();
}

DI float wave_max(float v) {
#pragma unroll
    for (int o = 1; o < 64; o <<= 1) v = fmaxf(v, __shfl_xor(v, o));
    return v; }
DI void peer_table_rows(const Args& a, int gw, int NGW, int lane, int rbeg, int rend) {
    for (int r0 = rbeg + gw * 4; r0 < rend; r0 += NGW * 4) {
        const bool dn = r0 < NEXP; const int e0 = dn ? r0 : r0 - NEXP;
        const float* srcb = (dn ? a.in[18] : a.in[19]) + (size_t)e0 * 1024;
        f32x4 v[4][2][2];
#pragma unroll
        for (int q = 0; q < 4; ++q)
#pragma unroll
            for (int j = 0; j < 2; ++j) { const int c = j * 512 + 8 * lane; v[q][j][0] = *(const f32x4*)(srcb + q * 1024 + c); v[q][j][1] = *(const f32x4*)(srcb + q * 1024 + c + 4); }
        f32x4 w[2][2];
#pragma unroll
        for (int j = 0; j < 2; ++j) { const int c = j * 512 + 8 * lane; w[j][0] = dn ? *(const f32x4*)(a.in[14] + c) : (f32x4){1.f, 1.f, 1.f, 1.f}; w[j][1] = dn ? *(const f32x4*)(a.in[14] + c + 4) : (f32x4){1.f, 1.f, 1.f, 1.f}; }
#pragma unroll
        for (int q = 0; q < 4; ++q) {
            float mx = 0.f;
#pragma unroll
            for (int j = 0; j < 2; ++j)
#pragma unroll
                for (int k = 0; k < 2; ++k) { v[q][j][k] *= w[j][k]; mx = fmaxf(mx, fmaxf(fmaxf(fabsf(v[q][j][k].x), fabsf(v[q][j][k].y)), fmaxf(fabsf(v[q][j][k].z), fabsf(v[q][j][k].w)))); }
            mx = wave_max(mx);
            const float sc = mx > 0.f ? mx * (dn ? (1.0f / 127.0f) : (1.0f / 416.0f)) : 1.0f, inv = 1.0f / sc; const int e = e0 + q;
            if (lane == 0) ((float*)(a.ws + (dn ? WS_DSC : WS_USC)))[e] = sc;
#pragma unroll
            for (int j = 0; j < 2; ++j) { const int c = j * 512 + 8 * lane; unsigned w0, w1;
                const f32x4 p = v[q][j][0] * inv, t = v[q][j][1] * inv;
                if (dn) { w0 = ((unsigned)(int)rintf(p.x) & 255u) | (((unsigned)(int)rintf(p.y) & 255u) << 8) | (((unsigned)(int)rintf(p.z) & 255u) << 16) | (((unsigned)(int)rintf(p.w) & 255u) << 24);
                          w1 = ((unsigned)(int)rintf(t.x) & 255u) | (((unsigned)(int)rintf(t.y) & 255u) << 8) | (((unsigned)(int)rintf(t.z) & 255u) << 16) | (((unsigned)(int)rintf(t.w) & 255u) << 24); }
                else { int t0 = __builtin_amdgcn_cvt_pk_fp8_f32(p.x, p.y, 0, false); t0 = __builtin_amdgcn_cvt_pk_fp8_f32(p.z, p.w, t0, true);
                       int t1 = __builtin_amdgcn_cvt_pk_fp8_f32(t.x, t.y, 0, false); t1 = __builtin_amdgcn_cvt_pk_fp8_f32(t.z, t.w, t1, true); w0 = (unsigned)t0; w1 = (unsigned)t1; }
                *(u32x2*)(a.ws + (dn ? WS_DOWN : WS_UP) + ((size_t)(c >> 7) * NEXP + e) * 128 + (c & 127)) = (u32x2){w0, w1}; }
        }
    }
}
DI void wk_quant_rows(const Args& a, int gw, int NGW, int lane) {
    for (int r = gw; r < 2048; r += NGW) {
        const bf16* src = (const bf16*)(a.ws + WS_WQ) + (size_t)r * 1024 + 16 * lane;
        float f0[8], f1[8]; unpack8(*(const u32x4*)src, f0); unpack8(*(const u32x4*)(src + 8), f1);
        float mx = 0.f;
#pragma unroll
        for (int e = 0; e < 8; ++e) mx = fmaxf(mx, fmaxf(fabsf(f0[e]), fabsf(f1[e])));
        mx = wave_max(mx);
        const float sc = mx > 0.f ? mx * (1.0f / 127.0f) : 1.0f, inv = 1.0f / sc;
        if (lane == 0) ((float*)(a.ws + WS_WKSC))[r] = sc;
        u32x4 w;
#define Q4(x0, x1, x2, x3) (((unsigned)(int)rintf((x0) * inv) & 255u) | (((unsigned)(int)rintf((x1) * inv) & 255u) << 8) | (((unsigned)(int)rintf((x2) * inv) & 255u) << 16) | (((unsigned)(int)rintf((x3) * inv) & 255u) << 24))
        w.x = Q4(f0[0], f0[1], f0[2], f0[3]); w.y = Q4(f0[4], f0[5], f0[6], f0[7]); w.z = Q4(f1[0], f1[1], f1[2], f1[3]); w.w = Q4(f1[4], f1[5], f1[6], f1[7]);
#undef Q4
        *(u32x4*)(a.ws + WS_WK8 + (size_t)r * 1024 + 16 * lane) = w;
    }
}
DI void x2_quant_rows(const Args& a, int gw, int NGW, int lane) {
    for (int m0 = gw * 4; m0 < M; m0 += NGW * 4) {
        f32x4 v[4][4];
#pragma unroll
        for (int q = 0; q < 4; ++q) { const u32x2* xr = (const u32x2*)((const bf16*)(a.ws + WS_X2B) + (size_t)(m0 + q) * DM) + lane;
#pragma unroll
            for (int j = 0; j < 4; ++j) { const u32x2 w = xr[64 * j]; v[q][j] = (f32x4){__builtin_bit_cast(float, w.x << 16), __builtin_bit_cast(float, w.x & 0xffff0000u), __builtin_bit_cast(float, w.y << 16), __builtin_bit_cast(float, w.y & 0xffff0000u)}; } }
#pragma unroll
        for (int q = 0; q < 4; ++q) { float mx = 0.f;
#pragma unroll
            for (int j = 0; j < 4; ++j) mx = fmaxf(mx, fmaxf(fmaxf(fabsf(v[q][j].x), fabsf(v[q][j].y)), fmaxf(fabsf(v[q][j].z), fabsf(v[q][j].w))));
            mx = wave_max(mx);
            const float sc = mx > 0.f ? mx * (1.0f / 127.0f) : 1.0f, inv = 1.0f / sc;
            if (lane == 0) ((float*)(a.ws + WS_XSC))[m0 + q] = sc;
            unsigned* o = (unsigned*)(a.ws + WS_X2Q + (size_t)(m0 + q) * DM) + lane;
#pragma unroll
            for (int j = 0; j < 4; ++j) { const f32x4 p = v[q][j] * inv;
                o[64 * j] = ((unsigned)(int)rintf(p.x) & 255u) | (((unsigned)(int)rintf(p.y) & 255u) << 8) | (((unsigned)(int)rintf(p.z) & 255u) << 16) | (((unsigned)(int)rintf(p.w) & 255u) << 24); } }
    }
}

#define XB_TMO      128
#define XB_XCNT(j)  (256  + 64 * (j))
#define XB_XSUB(j)  (1280 + 64 * (j))
#define XB_XGEN(j)  (2304 + 64 * (j))
#define XB_TOP      3328
#define XB_TOPGEN   3392
#define XCD_BAR_WORDS 3456
#define XB_SPIN_CAP (1u << 22)
DI unsigned xb_ld(unsigned* p)              { return __hip_atomic_load(p, __ATOMIC_RELAXED, __HIP_MEMORY_SCOPE_AGENT); }
DI unsigned xb_add(unsigned* p, unsigned v) { return __hip_atomic_fetch_add(p, v, __ATOMIC_RELAXED, __HIP_MEMORY_SCOPE_AGENT); }
DI unsigned xb_xcc_id() { return (unsigned)__builtin_amdgcn_s_getreg((3 << 11) | 20) & 0xFu; }
#define XB_SPIN(cond, bar) do { unsigned _sp = 0; while (cond) { __builtin_amdgcn_s_sleep(1); \
    if ((++_sp & 255u) == 0u) { if (xb_ld(&(bar)[XB_TMO])) break; if (_sp > XB_SPIN_CAP) { atomicAdd(&(bar)[XB_TMO], 1u); break; } } } } while (0)
DI void xcd_barrier_complete(unsigned* bar, unsigned x, unsigned& nloc, unsigned& nx) {
    const unsigned G = gridDim.x * gridDim.y * gridDim.z;
    unsigned sum, cnt, mine, sp = 0u;
    for (;;) {
        sum = 0u; cnt = 0u; mine = 0u;
#pragma unroll
        for (unsigned j = 0; j < 16; ++j) { const unsigned c = xb_ld(&bar[XB_XCNT(j)]); sum += c; cnt += (c > 0u) ? 1u : 0u; mine = (j == x) ? c : mine; }
        if (sum == G) break;
        __builtin_amdgcn_s_sleep(1);
        if ((++sp & 255u) == 0u) { if (xb_ld(&bar[XB_TMO])) break; if (sp > XB_SPIN_CAP) { atomicAdd(&bar[XB_TMO], 1u); break; } }
    }
    nloc = mine > 0u ? mine : 1u; nx = cnt > 0u ? cnt : 1u;
}
DI void xcd_barrier(unsigned* bar, volatile LAS unsigned* st, bool leader) {
    asm volatile("s_waitcnt vmcnt(0)" ::: "memory");
    __syncthreads();
    if (leader) {
        const unsigned x = xb_xcc_id();
        __builtin_amdgcn_s_waitcnt(0);
        unsigned nloc = st[0], nx = st[1];
        if (nloc == 0u) { xcd_barrier_complete(bar, x, nloc, nx); st[0] = nloc; st[1] = nx; }
        const unsigned old = xb_add(&bar[XB_XSUB(x)], 1u);
        const unsigned gen = old / nloc;
        if (old + 1u == (gen + 1u) * nloc) {
            __builtin_amdgcn_fence(__ATOMIC_RELEASE, "agent");
            asm volatile("s_waitcnt vmcnt(0)" ::: "memory");
            const unsigned og = xb_add(&bar[XB_TOP], 1u);
            const unsigned tg = og / nx;
            if (og + 1u == (tg + 1u) * nx) xb_add(&bar[XB_TOPGEN], 1u);
            else XB_SPIN(xb_ld(&bar[XB_TOPGEN]) == tg, bar);
            __builtin_amdgcn_fence(__ATOMIC_ACQUIRE, "agent");
            xb_add(&bar[XB_XGEN(x)], 1u);
            asm volatile("s_waitcnt vmcnt(0)" ::: "memory");
        } else {
            XB_SPIN(xb_ld(&bar[XB_XGEN(x)]) == gen, bar);
            __builtin_amdgcn_fence(__ATOMIC_ACQUIRE, "agent");
            asm volatile("s_waitcnt vmcnt(0)" ::: "memory");
        }
    }
    __syncthreads();
}
#if GDN_CMP
__global__ void __launch_bounds__(NTHREADS, 2) gdn_v1_kernel(Args a) {
    extern __shared__ __attribute__((aligned(16))) unsigned char lds_raw2[];
    gdn_seq(a, blockIdx.x, (LAS unsigned char*)lds_raw2, threadIdx.x);
}
#endif
#if GDN_CMP
__global__ void __launch_bounds__(NTHREADS, 2) gdn_v2_dbg_kernel(Args a) {
    extern __shared__ __attribute__((aligned(16))) unsigned char lds_raw3[];
    LAS unsigned char* lds = (LAS unsigned char*)lds_raw3; unsigned char* ws = a.ws;
    const int tid = threadIdx.x, lane = tid & 63, wave = __builtin_amdgcn_readfirstlane(tid >> 6), bh = blockIdx.x;
                const int fcode = gdn_chunked(a, bh, lds, wave, lane, (bf16*)a.out);
                __syncthreads();
                { const bf16* O1 = (const bf16*)(ws + WS_OB); const bf16* O2 = (const bf16*)a.out; float sd = 0.f, sr = 0.f;
                  for (int e = tid; e < (GDN_CMP_T1 - GDN_CMP_T0) * 128; e += NTHREADS) { const size_t off = ((size_t)((bh >> 3) * SEQ + GDN_CMP_T0 + (e >> 7))) * 1024 + (bh & 7) * 128 + (e & 127);
                      const float r1 = bflo((unsigned)O1[off]), d = r1 - bflo((unsigned)O2[off]); sd += d * d; sr += r1 * r1; }
                  sd = wave_sum(sd); sr = wave_sum(sr);
                  LAS float* red = (LAS float*)lds; if (lane == 0) { red[wave] = sd; red[8 + wave] = sr; } __syncthreads();
                  float ad = 0.f, ar = 0.f; for (int w2 = 0; w2 < 8; ++w2) { ad += red[w2]; ar += red[8 + w2]; }
                  if (ad > GDN_CMP_THR * ar || fcode) { const unsigned pz = fcode == 1 ? 0x47c3u : (fcode == 2 ? 0x461cu : (fcode == 3 ? 0x447au : (fcode == 4 ? 0x42c8u : 0x4120u))); bf16* O1w = (bf16*)(ws + WS_OB); for (int e = tid; e < 64 * 128; e += NTHREADS) O1w[((size_t)((bh >> 3) * SEQ + (e >> 7))) * 1024 + (bh & 7) * 128 + (e & 127)] = (bf16)pz; }
                  __syncthreads(); }
}
#endif
DI int lane_id_opaque() { int l = (int)__builtin_amdgcn_mbcnt_hi(~0u, __builtin_amdgcn_mbcnt_lo(~0u, 0u)); asm volatile("" : "+v"(l)); return l; }
__global__ void __launch_bounds__(NTHREADS, 2) fwd_kernel(Args a_in) {
    extern __shared__ __attribute__((aligned(16))) unsigned char lds_raw[];
    LAS unsigned char* lds = (LAS unsigned char*)lds_raw;
    int wave_ = __builtin_amdgcn_readfirstlane((int)threadIdx.x >> 6); asm volatile("" : "+s"(wave_));
    const int wave = wave_;
#define LANE_ID() lane_id_opaque()
    const int G = gridDim.x, bx = blockIdx.x;
    const int gw = bx * NWAVES + wave, NGW = G * NWAVES;
#define FRESH_ARGS() const __attribute__((address_space(4))) Args* kp_ = (const __attribute__((address_space(4))) Args*)__builtin_amdgcn_kernarg_segment_ptr(); asm volatile("" : "+s"(kp_)); Args a; _Pragma("unroll") for (int i_ = 0; i_ < 20; ++i_) a.in[i_] = kp_->in[i_]; a.out = kp_->out; a.ws = kp_->ws; a.ph_lo = kp_->ph_lo; a.ph_hi = kp_->ph_hi; a.probe = kp_->probe; a.dry = kp_->dry; unsigned char* ws = a.ws; (void)ws
    volatile LAS unsigned* bar_st = (volatile LAS unsigned*)(lds + LDS_BYTES - 64);
#if MK_ONE_LAUNCH
    { const int l0 = LANE_ID(); if (wave == 0 && l0 < 2) bar_st[l0] = 0u; __syncthreads();
      if (wave == 0 && l0 == 0) (void)xb_add((unsigned*)(a_in.ws + WS_CTL) + XB_XCNT(xb_xcc_id()), 1u); }
#define GRID_BAR() do { FRESH_ARGS(); xcd_barrier((unsigned*)(a.ws + WS_CTL), bar_st, wave == 0 && LANE_ID() == 0); } while (0)
#else
#define GRID_BAR() do {} while (0)
#endif
    const int lo = a_in.ph_lo, hi = a_in.ph_hi;
#define IN(k) (lo <= (k) && (k) < hi)
#define SEAM(k) do { if (IN(k) && IN((k) + 1) && !((k) == 3 && G >= 256)) GRID_BAR(); } while (0)
    typedef pg8::bf16_t pbf;
#define REP(k) for (int rep_ = (MK_PROBE == (k)) ? 0 : 1; rep_ < 2; ++rep_)
    if (IN(0)) REP(0) { FRESH_ARGS(); phase0(a, lds, gw, NGW, wave, LANE_ID()); }
    SEAM(0);
    if (IN(1)) REP(1) {
        FRESH_ARGS();
        wk_quant_rows(a, gw, NGW, LANE_ID());
        ab_rows(a, bx, wave, LANE_ID());
#if P1_FP8
        {
            pg8::Gemm g{(const pbf*)(ws + WS_H8), (const pbf*)(ws + WS_W8), M, P1_FP8_UPTO, 512}; pg8::StaticOrder S; S.init(M, P1_FP8_UPTO, G, bx);
            pg8::EpiIn E{ws, (pbf*)a.out + (size_t)M * DM, a.in[10], a.in[7], a.in[8], 0};
            pg8::gemm_phase<pg8::EpiIn, pg8::StaticOrder, true, true, true>(lds, g, S, E, wave);
        }
        if (P1_FP8_UPTO < NIN - 256) {
            pg8::Gemm g{(const pbf*)a.out, (const pbf*)(ws + WS_WIN) + (size_t)P1_FP8_UPTO * 1024, M, NIN - 256 - P1_FP8_UPTO, 1024}; pg8::StaticOrder S; S.init(M, NIN - 256 - P1_FP8_UPTO, G, bx);
            pg8::EpiIn E{ws, (pbf*)a.out + (size_t)M * DM, a.in[10], a.in[7], a.in[8], P1_FP8_UPTO / 256};
            pg8::gemm_phase<pg8::EpiIn, pg8::StaticOrder, true, true, false>(lds, g, S, E, wave);
        }
#else
        { pg8::Gemm g{(const pbf*)a.out, (const pbf*)(ws + WS_WIN), M, NIN - 256, 1024}; pg8::StaticOrder S; S.init(M, NIN - 256, G, bx);
          pg8::EpiIn E{ws, (pbf*)a.out + (size_t)M * DM, a.in[10], a.in[7], a.in[8], 0};
          pg8::gemm_phase<pg8::EpiIn, pg8::StaticOrder, true, true, false>(lds, g, S, E, wave); }
#endif
    }
    SEAM(1);
    if (IN(2)) REP(2) {
        __syncthreads();
        if (bx < 128 || G < 256) {
            for (int grep_ = (MK_PROBE == 20) ? 0 : 1; grep_ < 2; ++grep_)
            for (int bh = bx; bh < 128; bh += (G < 256 ? G : 128)) {
                FRESH_ARGS();
#if GDN_V1
                gdn_seq(a, bh, lds, wave * 64 + LANE_ID());
#elif GDN_CMP
                (void)bh;
#else
                gdn_chunked(a, bh, lds, wave, LANE_ID(), (bf16*)(ws + WS_OB));
#endif
            }
        }
        if (G >= 256) {
            if (bx >= 128) {
                { FRESH_ARGS(); peer_table_rows(a, (bx - 128) * 8 + wave, 1024, LANE_ID(), 0, TBL_P2_ROWS); }
                const int pm = bx - 128;
                for (int arep_ = (MK_PROBE == 22) ? 0 : 1; arep_ < 2; ++arep_)
                for (int i4 = 0; i4 < 4; ++i4) { FRESH_ARGS(); const bool dry = (rep_ == 0) || (arep_ == 0) || (a.dry != 0); attn_unit(a, pm >> 3, 4 * (pm & 7) + i4, lds + wave * 18432, wave, LANE_ID(), dry); }
                asm volatile("s_waitcnt vmcnt(0)" ::: "memory"); __syncthreads();
                if (wave == 0) { __builtin_amdgcn_fence(__ATOMIC_RELEASE, "agent"); __builtin_amdgcn_fence(__ATOMIC_ACQUIRE, "agent"); asm volatile("s_waitcnt vmcnt(0)" ::: "memory"); }
                __syncthreads();
                { FRESH_ARGS();
                  pg8::Gemm g{(const pbf*)(ws + WS_QA), (const pbf*)(ws + WS_WPA), M, 1024, 512}; pg8::RowTileOrder S{pm, 4};
                  pg8::EpiMix<false> E{(pbf*)a.out, ws + WS_MERGE, nullptr};
                  pg8::gemm_phase<pg8::EpiMix<false>, pg8::RowTileOrder, true, true>(lds, g, S, E, wave); }
            }
        }
        __syncthreads();
    }
    SEAM(2);
    SEAM(3);
    if (IN(4)) {
        FRESH_ARGS();
        pg8::Gemm g{(const pbf*)(ws + WS_OB), (const pbf*)(ws + WS_WPB), M, 1024, 1024}; pg8::StaticOrder S; S.init(M, 1024, G, bx);
        pg8::EpiMix<true> E{(pbf*)(ws + WS_MIXED), ws + WS_MERGE + 1024, (const pbf*)a.out};
        pg8::gemm_phase<pg8::EpiMix<true>, pg8::StaticOrder, true, true>(lds, g, S, E, wave);
    }
    SEAM(4);
    if (IN(5)) REP(5) {
        FRESH_ARGS();
        peer_table_rows(a, gw, NGW, LANE_ID(), TBL_P2_ROWS, 2 * NEXP);
        { pg8::Gemm g{(const pbf*)(ws + WS_MIXED), (const pbf*)(ws + WS_WOUT), M, 1024, 1024}; pg8::StaticOrder S; S.init(M, 1024, G, bx);
          pg8::EpiOut E{a.in[0], a.out, (pbf*)(ws + WS_X2B), (float*)(ws + WS_SSQ)};
          pg8::gemm_phase<pg8::EpiOut, pg8::StaticOrder, true, true>(lds, g, S, E, wave); }
    }
    SEAM(5);
    if (IN(6)) REP(6) {
        FRESH_ARGS();
        x2_quant_rows(a, gw, NGW, LANE_ID());
        GRID_BAR();
        { FRESH_ARGS();
          pg8::Gemm g{(const pbf*)(ws + WS_X2Q), (const pbf*)(ws + WS_WK8), M, 2048, 512}; pg8::StaticOrder S; S.init(M, 2048, G, bx);
          pg8::EpiScore E{(pbf*)(ws + WS_QP), (const float*)(ws + WS_XSC), (const float*)(ws + WS_WKSC)};
          pg8::gemm_phase<pg8::EpiScore, pg8::StaticOrder, true, true, false, true>(lds, g, S, E, wave); }
    }
    SEAM(6);
    if (IN(7)) REP(7) {
        __syncthreads();
        for (int t = bx; t < M / 128; t += G) { FRESH_ARGS(); const bool dry = (rep_ == 0) || (a.dry != 0); peer_group(a, t, lds, wave, LANE_ID(), dry); }
    }
#undef IN
#undef SEAM
}

extern "C" void kernel_launch(void* const* d_in, const int* in_sizes, int n_in, void* d_out, int out_size, void* d_ws, size_t ws_size, hipStream_t stream) {
    static int grid = 0;
    if (grid == 0) {
        if (n_in != 20 || out_size != M * DM || ws_size < WS_END) { fprintf(stderr, "kernel_launch: unexpected problem (n_in %d, out %d, ws %zu); nothing launched\n", n_in, out_size, ws_size); grid = -1; return; }
        int dev = 0, cus = 0, per_cu = 0;
        if (hipGetDevice(&dev) != hipSuccess || hipDeviceGetAttribute(&cus, hipDeviceAttributeMultiprocessorCount, dev) != hipSuccess) { grid = -1; return; }
        if (hipFuncSetAttribute((const void*)fwd_kernel, hipFuncAttributeMaxDynamicSharedMemorySize, LDS_BYTES) != hipSuccess) { fprintf(stderr, "kernel_launch: hipFuncSetAttribute failed\n"); grid = -1; return; }
        if (hipOccupancyMaxActiveBlocksPerMultiprocessor(&per_cu, (const void*)fwd_kernel, NTHREADS, LDS_BYTES) != hipSuccess || per_cu < 1) { fprintf(stderr, "kernel_launch: occupancy query says %d\n", per_cu); per_cu = 1; }
        (void)hipGetLastError();
        grid = cus;
        if (grid != 256) { fprintf(stderr, "kernel_launch: this kernel is built for a 256-CU device (got %d)\n", grid); grid = 256; }
    }
    if (grid < 0) return;
    (void)hipMemsetAsync((char*)d_ws + WS_CTL, 0, CTL_ZERO_BYTES, stream);
    Args a{};
    for (int i = 0; i < 20; ++i) a.in[i] = (const float*)d_in[i];
    a.out = (float*)d_out; a.ws = (unsigned char*)d_ws; a.probe = MK_PROBE; a.dry = 0;
#if MK_ONE_LAUNCH
    a.ph_lo = 0; a.ph_hi = N_PHASES;
    void* args[] = {&a};
    hipError_t e = hipLaunchCooperativeKernel((const void*)fwd_kernel, dim3(grid), dim3(NTHREADS), args, LDS_BYTES, stream);
    if (e != hipSuccess) fprintf(stderr, "kernel_launch: cooperative launch failed: %s (grid %d)\n", hipGetErrorString(e), grid);
#else
    for (int p = 0; p < N_PHASES; ++p) {
#if GDN_CMP
        if (p == 2) { (void)hipFuncSetAttribute((const void*)gdn_v1_kernel, hipFuncAttributeMaxDynamicSharedMemorySize, LDS_BYTES); hipLaunchKernelGGL(gdn_v1_kernel, dim3(128), dim3(NTHREADS), LDS_BYTES, stream, a);
            (void)hipFuncSetAttribute((const void*)gdn_v2_dbg_kernel, hipFuncAttributeMaxDynamicSharedMemorySize, LDS_BYTES); hipLaunchKernelGGL(gdn_v2_dbg_kernel, dim3(128), dim3(NTHREADS), LDS_BYTES, stream, a); }
#endif
        a.ph_lo = p; a.ph_hi = p + 1;
        hipLaunchKernelGGL(fwd_kernel, dim3(grid), dim3(NTHREADS), LDS_BYTES, stream, a);
    }
#endif
}
```

```cpp
#include <hip/hip_runtime.h>
#include <cstdio>
#include <cstdint>
namespace pg8 {
#define PG8_LAS __attribute__((address_space(3)))
typedef unsigned short bf16_t;
typedef short bf16x8 __attribute__((ext_vector_type(8)));
typedef float f32x4 __attribute__((ext_vector_type(4)));
typedef unsigned u32x4 __attribute__((ext_vector_type(4)));
constexpr int BM = 256, BK = 64, HALF = 128, HTB = HALF * BK * 2  , STAGE_BYTES = 8 * HTB, NXCD = 8, WGM = 8;

__host__ __device__ __forceinline__ int lds_byte(int r, int c) { const int st = (r >> 4) * 2 + (c >> 5), rr = r & 15, cc = c & 31, ob = rr * 64 + cc * 2; return st * 1024 + (ob ^ (((ob >> 9) & 1) << 5)); }
__host__ __device__ __forceinline__ void stage_rc(int b, int& R, int& C) { const int st = b / 1024, sb = b % 1024, swz = sb ^ (((sb >> 9) & 1) << 5); R = (st >> 1) * 16 + swz / 64; C = (st & 1) * 32 + (swz % 64) / 2; }
__host__ __device__ __forceinline__ int perm32(int rho) { const int n = rho >> 4, i = rho & 15; return 8 * (i >> 2) + 4 * n + (i & 3); }

struct Unit { int pm, pn; };
struct Gemm { const bf16_t* A; const bf16_t* Bt; int M, N, K; };

struct StaticOrder {
    int nM, nN, nwg, G, c;
    __host__ __device__ void init(int M, int N, int G_, int c_) { nM = M / BM; nN = N / BM; nwg = nM * nN; G = G_; c = c_; }
    __host__ __device__ bool next(int i, Unit& u) const {
        const long L = (long)i * G + c; if (L >= nwg) return false;
        int wgid = (int)L; { const int q = nwg / NXCD, r = nwg % NXCD, xcd = wgid % NXCD, off = wgid / NXCD; wgid = (xcd < r ? xcd * (q + 1) : r * (q + 1) + (xcd - r) * q) + off; }
        const int nig = WGM * nN, gid = wgid / nig, fm = gid * WGM, gsz = (nM - fm) < WGM ? (nM - fm) : WGM;
        u.pm = fm + ((wgid % nig) % gsz); u.pn = (wgid % nig) / gsz; return true;
    }
    __device__ __forceinline__ void a_ready(const Unit&) const {}
    __device__ __forceinline__ void done(const Unit&) const {}
};

__device__ __forceinline__ unsigned cvt_pk_bf16(float lo, float hi) { unsigned r; asm volatile("v_cvt_pk_bf16_f32 %0, %1, %2" : "=v"(r) : "v"(lo), "v"(hi)); return r; }
typedef float f32x2 __attribute__((ext_vector_type(2)));
__device__ __forceinline__ const char* pg8_uptr(const char* p) { const unsigned long long v = (unsigned long long)p; const unsigned lo = (unsigned)__builtin_amdgcn_readfirstlane((int)(unsigned)v), hi = (unsigned)__builtin_amdgcn_readfirstlane((int)(unsigned)(v >> 32)); return (const char*)(((unsigned long long)hi << 32) | lo); }
typedef int v8i_t __attribute__((ext_vector_type(8))); typedef int v4i_t __attribute__((ext_vector_type(4)));
template <class Epi, class Sched, bool ALIGN_EPI = false, bool SP2 = false, bool FP8 = false, bool I8 = false>
__device__ __forceinline__ void gemm_phase(PG8_LAS unsigned char* lds, const Gemm g, const Sched& S, const Epi& E, const int wid  ) {
    int lane_ = (int)__builtin_amdgcn_mbcnt_hi(~0u, __builtin_amdgcn_mbcnt_lo(~0u, 0u)); asm volatile("" : "+v"(lane_));
    const int lane = lane_, tid = wid * 64 + lane,     wr = wid >> 2, wc = wid & 3, fr = lane & 15, fq = lane >> 4;
    const int K = g.K, nt = K / BK;
    unsigned voffA[2], voffB[2];
#pragma unroll
    for (int i = 0; i < 2; ++i) { int R, C; stage_rc(tid * 16 + i * 8192, R, C); const int Rb = Epi::PERM ? ((R & ~31) + perm32(R & 31)) : R;
        voffA[i] = (unsigned)(R * K + C) * 2u; voffB[i] = (unsigned)(Rb * K + C) * 2u; }
    const size_t kstep = (size_t)(BK * 2);
    const size_t hstep = (size_t)HALF * K * 2;
    const size_t tstep = 2 * hstep;
    const unsigned ldsw = (unsigned)wid * 1024u;
    const int aoff = lds_byte(wr * 64 + fr, fq * 8), boff = lds_byte(wc * 32 + fr, fq * 8);
#define PG8_SA(b, h) (((b) * 2 + (h)) * HTB)
#define PG8_SB(b, h) ((4 + (b) * 2 + (h)) * HTB)
#define PG8_STAGE(bufoff, gbase, voff) do { const char* gb_ = pg8_uptr((const char*)(gbase)); _Pragma("unroll") for (int _i = 0; _i < 2; ++_i) \
        __builtin_amdgcn_global_load_lds((const unsigned*)(gb_ + (voff)[_i]), (PG8_LAS unsigned*)(lds + (bufoff) + ldsw + _i * 8192), 16, 0, 0); } while (0)
#define PG8_LDA(dst, b, h) do { if constexpr (FP8) { _Pragma("unroll") for (int m = 0; m < 4; ++m) dst##8[m] = PG8_CAT(*(const PG8_LAS v4i_t*)(lds + PG8_SA(b, h) + aoff + m * 2048), *(const PG8_LAS v4i_t*)(lds + PG8_SA(b, h) + aoff + m * 2048 + 1024)); } \
        else { _Pragma("unroll") for (int m = 0; m < 4; ++m) _Pragma("unroll") for (int k = 0; k < 2; ++k) dst[m][k] = *(const PG8_LAS bf16x8*)(lds + PG8_SA(b, h) + aoff + m * 2048 + k * 1024); } } while (0)
#define PG8_LDB(dst, b, h) do { if constexpr (FP8) { _Pragma("unroll") for (int n = 0; n < 2; ++n) dst##8[n] = PG8_CAT(*(const PG8_LAS v4i_t*)(lds + PG8_SB(b, h) + boff + n * 2048), *(const PG8_LAS v4i_t*)(lds + PG8_SB(b, h) + boff + n * 2048 + 1024)); } \
        else { _Pragma("unroll") for (int n = 0; n < 2; ++n) _Pragma("unroll") for (int k = 0; k < 2; ++k) dst[n][k] = *(const PG8_LAS bf16x8*)(lds + PG8_SB(b, h) + boff + n * 2048 + k * 1024); } } while (0)
#define PG8_CAT(x0, x1) __builtin_shufflevector((x0), (x1), 0, 1, 2, 3, 4, 5, 6, 7)
#define PG8_MMA(ai, bj, At, Bt) do { __builtin_amdgcn_s_setprio(1); _Pragma("unroll") for (int m = 0; m < 4; ++m) _Pragma("unroll") for (int n = 0; n < 2; ++n) { \
        if constexpr (FP8) acc[ai][bj][m][n] = __builtin_amdgcn_mfma_scale_f32_16x16x128_f8f6f4(Bt##8[n], At##8[m], acc[ai][bj][m][n], 0, 0, 0, 0x77777777, 0, 0x7f7f7f7f); \
        else if constexpr (I8) { _Pragma("unroll") for (int k = 0; k < 2; ++k) acc[ai][bj][m][n] = __builtin_bit_cast(f32x4, __builtin_amdgcn_mfma_i32_16x16x64_i8(__builtin_bit_cast(v4i_t, Bt[n][k]), __builtin_bit_cast(v4i_t, At[m][k]), __builtin_bit_cast(v4i_t, acc[ai][bj][m][n]), 0, 0, 0)); } \
        else { _Pragma("unroll") for (int k = 0; k < 2; ++k) acc[ai][bj][m][n] = __builtin_amdgcn_mfma_f32_16x16x32_bf16(Bt[n][k], At[m][k], acc[ai][bj][m][n], 0, 0, 0); } } __builtin_amdgcn_s_setprio(0); } while (0)
#define PG8_WAIT_V(n) asm volatile("s_waitcnt vmcnt(" #n ")" ::: "memory")
#define PG8_WAIT_L(n) asm volatile("s_waitcnt lgkmcnt(" #n ")" ::: "memory")
#define PG8_BAR __builtin_amdgcn_s_barrier()
#define PG8_SCHED __builtin_amdgcn_sched_barrier(0)
    Unit cur, nxt; int ui = 0;
    if (!S.next(0, cur)) return;
    f32x4 acc[2][2][4][2];
#pragma unroll
    for (int a = 0; a < 2; ++a)
#pragma unroll
        for (int b = 0; b < 2; ++b)
#pragma unroll
            for (int m = 0; m < 4; ++m)
#pragma unroll
                for (int n = 0; n < 2; ++n) acc[a][b][m][n] = (f32x4){0.f, 0.f, 0.f, 0.f};
    bf16x8 At[4][2], B0[2][2], B1[2][2];
    v8i_t At8[4], B08[2], B18[2];
    const char* cA = (const char*)g.A + (size_t)cur.pm * tstep; const char* cB = (const char*)g.Bt + (size_t)cur.pn * tstep;
    S.a_ready(cur);
    if constexpr (SP2) {
        PG8_STAGE(PG8_SB(0, 0), cB, voffB); PG8_STAGE(PG8_SB(0, 1), cB + hstep, voffB); PG8_STAGE(PG8_SA(0, 0), cA, voffA); PG8_STAGE(PG8_SA(0, 1), cA + hstep, voffA);
        if (wr == 1) PG8_BAR;
        PG8_WAIT_V(2); PG8_BAR;
        PG8_STAGE(PG8_SB(1, 0), cB + kstep, voffB); PG8_STAGE(PG8_SA(1, 0), cA + kstep, voffA); PG8_STAGE(PG8_SB(1, 1), cB + hstep + kstep, voffB);
        PG8_WAIT_V(6); PG8_BAR;
    } else {
        PG8_STAGE(PG8_SB(0, 0), cB, voffB); PG8_STAGE(PG8_SA(0, 0), cA, voffA); PG8_STAGE(PG8_SB(0, 1), cB + hstep, voffB); PG8_STAGE(PG8_SA(0, 1), cA + hstep, voffA);
        if (wr == 1) PG8_BAR;
        PG8_WAIT_V(4); PG8_BAR;
        PG8_STAGE(PG8_SB(1, 0), cB + kstep, voffB); PG8_STAGE(PG8_SA(1, 0), cA + kstep, voffA); PG8_STAGE(PG8_SB(1, 1), cB + hstep + kstep, voffB);
        PG8_WAIT_V(6); PG8_BAR;
    }
    for (;;) {
        const bool has_next = S.next(ui + 1, nxt);
        const char* nA = has_next ? (const char*)g.A + (size_t)nxt.pm * tstep : cA; const char* nB = has_next ? (const char*)g.Bt + (size_t)nxt.pn * tstep : cB;
_Pragma("unroll 1")
        for (int t = 0; t < nt; t += 2) {
            const bool last = (t == nt - 2);
            const char* a1 = cA + (size_t)(t + 1) * kstep;
            const char* a2 = last ? nA : cA + (size_t)(t + 2) * kstep; const char* b2 = last ? nB : cB + (size_t)(t + 2) * kstep;
            const char* a3 = a2 + kstep; const char* b3 = b2 + kstep;
            if (last && has_next) S.a_ready(nxt);
            if constexpr (SP2) {
            PG8_LDB(B0, 0, 0); PG8_LDB(B1, 0, 1); PG8_SCHED; PG8_LDA(At, 0, 0); PG8_STAGE(PG8_SA(1, 1), a1 + hstep, voffA);
            PG8_WAIT_V(8); PG8_WAIT_L(0); PG8_BAR; PG8_MMA(0, 0, At, B0); PG8_MMA(0, 1, At, B1); PG8_BAR; PG8_SCHED;
            PG8_LDA(At, 0, 1); PG8_STAGE(PG8_SB(0, 0), b2, voffB); PG8_STAGE(PG8_SB(0, 1), b2 + hstep, voffB); PG8_STAGE(PG8_SA(0, 0), a2, voffA);
            PG8_WAIT_V(8); PG8_WAIT_L(0); PG8_BAR; PG8_MMA(1, 0, At, B0); PG8_MMA(1, 1, At, B1); PG8_BAR; PG8_SCHED;
            PG8_LDB(B0, 1, 0); PG8_LDB(B1, 1, 1); PG8_SCHED; PG8_LDA(At, 1, 0); PG8_STAGE(PG8_SA(0, 1), a2 + hstep, voffA);
            PG8_WAIT_V(8); PG8_WAIT_L(0); PG8_BAR; PG8_MMA(0, 0, At, B0); PG8_MMA(0, 1, At, B1); PG8_BAR; PG8_SCHED;
            PG8_LDA(At, 1, 1); PG8_STAGE(PG8_SB(1, 0), b3, voffB); PG8_STAGE(PG8_SB(1, 1), b3 + hstep, voffB); PG8_STAGE(PG8_SA(1, 0), a3, voffA);
            PG8_WAIT_V(8); PG8_WAIT_L(0); PG8_BAR; PG8_MMA(1, 0, At, B0); PG8_MMA(1, 1, At, B1); PG8_BAR; PG8_SCHED;
            } else {
            PG8_LDB(B0, 0, 0); PG8_SCHED; PG8_LDA(At, 0, 0); PG8_STAGE(PG8_SA(1, 1), a1 + hstep, voffA);
            PG8_WAIT_L(8); PG8_BAR; PG8_WAIT_L(0); PG8_MMA(0, 0, At, B0); PG8_BAR; PG8_SCHED;
            PG8_LDB(B1, 0, 1); PG8_STAGE(PG8_SB(0, 0), b2, voffB);
            PG8_BAR; PG8_WAIT_L(0); PG8_MMA(0, 1, At, B1); PG8_BAR;
            PG8_LDA(At, 0, 1); PG8_STAGE(PG8_SA(0, 0), a2, voffA);
            PG8_BAR; PG8_WAIT_L(0); PG8_MMA(1, 0, At, B0); PG8_BAR; PG8_SCHED;
            PG8_STAGE(PG8_SB(0, 1), b2 + hstep, voffB);
            PG8_WAIT_V(6); PG8_BAR; PG8_MMA(1, 1, At, B1); PG8_BAR;
            PG8_LDB(B0, 1, 0); PG8_SCHED; PG8_LDA(At, 1, 0); PG8_STAGE(PG8_SA(0, 1), a2 + hstep, voffA);
            PG8_WAIT_L(8); PG8_BAR; PG8_WAIT_L(0); PG8_MMA(0, 0, At, B0); PG8_BAR; PG8_SCHED;
            PG8_LDB(B1, 1, 1); PG8_STAGE(PG8_SB(1, 0), b3, voffB);
            PG8_BAR; PG8_WAIT_L(0); PG8_MMA(0, 1, At, B1); PG8_BAR;
            PG8_LDA(At, 1, 1); PG8_STAGE(PG8_SA(1, 0), a3, voffA);
            PG8_BAR; PG8_WAIT_L(0); PG8_MMA(1, 0, At, B0); PG8_BAR; PG8_SCHED;
            PG8_STAGE(PG8_SB(1, 1), b3 + hstep, voffB);
            PG8_WAIT_V(6); PG8_BAR; PG8_MMA(1, 1, At, B1); PG8_BAR;
            }
        }
        if constexpr (ALIGN_EPI) { if (wr == 0) PG8_BAR; }
        if constexpr (!Epi::AFTER_DRAIN) { E(acc, cur, wr, wc, fr, fq); S.done(cur); }
        if (!has_next) break;
#pragma unroll
        for (int a = 0; a < 2; ++a)
#pragma unroll
            for (int b = 0; b < 2; ++b)
#pragma unroll
                for (int m = 0; m < 4; ++m)
#pragma unroll
                    for (int n = 0; n < 2; ++n) acc[a][b][m][n] = (f32x4){0.f, 0.f, 0.f, 0.f};
        cur = nxt; cA = nA; cB = nB; ++ui;
        if constexpr (ALIGN_EPI) { if (wr == 1) PG8_BAR; }
    }
    PG8_WAIT_V(0);
    if constexpr (!ALIGN_EPI) { if (wr == 0) PG8_BAR; }
    PG8_BAR;
    if constexpr (Epi::AFTER_DRAIN) { E.fused(acc, cur, wr, wc, fr, fq, lds, wid, lane); S.done(cur); }
#undef PG8_SA
#undef PG8_SB
#undef PG8_STAGE
#undef PG8_LDA
#undef PG8_LDB
#undef PG8_MMA
#undef PG8_CAT
#undef PG8_WAIT_V
#undef PG8_WAIT_L
#undef PG8_BAR
#undef PG8_SCHED
}
}

#ifndef P1_FP8
#define P1_FP8 1
#endif
#ifndef P1_FP8_UPTO
#define P1_FP8_UPTO 7680
#endif
#ifndef GDN_CMP
#define GDN_CMP 0
#define GDN_CMP_T0 0
#define GDN_CMP_T1 64
#define GDN_CMP_THR 0.01f
#endif
#ifndef GDN_NCHUNK
#define GDN_NCHUNK 32
#endif
#ifndef GDN_CHK
#define GDN_CHK 0
#endif
#ifndef GDN_TDBG
#define GDN_TDBG 0
#endif
#ifndef GDN_V1
#define GDN_V1 0
#endif
#ifndef TBL_P2_ROWS
#define TBL_P2_ROWS 20480
#endif
#ifndef MK_PROBE
#define MK_PROBE -1
#endif
#ifndef MK_ONE_LAUNCH
#define MK_ONE_LAUNCH 1
#endif
constexpr int NWAVES = 8, NTHREADS = 512, N_PHASES = 8;

constexpr int BATCH = 16, SEQ = 2048, DM = 1024, M = BATCH * SEQ;
constexpr int NIN = 7936;
constexpr float EPS = 1e-6f;
constexpr int NEXP = 16384;

constexpr size_t MiB = 1u << 20;
constexpr size_t WS_CTL = 0, CTL_ZERO_BYTES = 64 * 1024;
constexpr size_t WS_WIN = 1 * MiB;
constexpr size_t WS_WPA = 17 * MiB;
constexpr size_t WS_WPB = 18 * MiB;
constexpr size_t WS_WOUT = 20 * MiB;
constexpr size_t WS_WQ = 22 * MiB;
constexpr size_t WS_KEYS = 26 * MiB;
constexpr size_t WS_AB = 27 * MiB;
constexpr size_t WS_SSQ = 29 * MiB;
constexpr size_t WS_QA = 32 * MiB, WS_KA = 64 * MiB, WS_VA = 96 * MiB;
constexpr size_t WS_QB = 128 * MiB, WS_KB = 192 * MiB, WS_VB = 256 * MiB;
constexpr size_t WS_MERGE = 320 * MiB;
constexpr size_t WS_OB = 448 * MiB;
constexpr size_t WS_H8 = WS_OB;
constexpr size_t WS_W8 = WS_OB + 32 * MiB;
constexpr size_t WS_END = 512 * MiB;
constexpr size_t WS_MIXED = WS_KA;
constexpr size_t WS_X2B = WS_QB;
constexpr size_t WS_QP = WS_KB;
constexpr size_t WS_DOWN = WS_MERGE + 64 * MiB;
constexpr size_t WS_UP = WS_MERGE + 80 * MiB;
constexpr size_t WS_DSC = WS_MERGE + 96 * MiB;
constexpr size_t WS_USC = WS_DSC + 65536;
constexpr size_t WS_WK8 = 2 * MiB;
constexpr size_t WS_WKSC = 4 * MiB;
constexpr size_t WS_X2Q = WS_KA;
constexpr size_t WS_XSC = WS_KA + 32 * MiB;

constexpr int LDS_BYTES = 154880 + 64;

#define GAS __attribute__((address_space(1)))
#define LAS __attribute__((address_space(3)))
#define DI __device__ __forceinline__
typedef unsigned short bf16;
typedef float f32x4 __attribute__((ext_vector_type(4)));
typedef float f32x16 __attribute__((ext_vector_type(16)));
typedef short bf16x8 __attribute__((ext_vector_type(8)));
typedef unsigned u32x4 __attribute__((ext_vector_type(4)));
typedef unsigned u32x2 __attribute__((ext_vector_type(2)));
typedef float f32x2v __attribute__((ext_vector_type(2)));

DI unsigned f2bf(float f) { unsigned u = __builtin_bit_cast(unsigned, f); return (u + 0x7fffu + ((u >> 16) & 1u)) >> 16; }
DI unsigned pk2(float lo, float hi) { return f2bf(lo) | (f2bf(hi) << 16); }
DI float bflo(unsigned u) { return __builtin_bit_cast(float, u << 16); }
DI float bfhi(unsigned u) { return __builtin_bit_cast(float, u & 0xffff0000u); }
DI float wave_sum(float v) {
#pragma unroll
    for (int o = 1; o < 64; o <<= 1) v += __shfl_xor(v, o);
    return v;
}
DI float sigmoidf_(float x) { return 1.0f / (1.0f + __expf(-x)); }
DI float softplusf_(float x) { return fmaxf(x, 0.f) + log1pf(__expf(-fabsf(x))); }
DI int crow(int reg, int h) { return (reg & 3) + 8 * (reg >> 2) + 4 * h; }
DI void unpack8(const u32x4 r, float (&f)[8]) {
    f[0] = bflo(r.x); f[1] = bfhi(r.x); f[2] = bflo(r.y); f[3] = bfhi(r.y); f[4] = bflo(r.z); f[5] = bfhi(r.z); f[6] = bflo(r.w); f[7] = bfhi(r.w);
}
DI u32x4 pack8(const float (&f)[8]) { u32x4 r; r.x = pk2(f[0], f[1]); r.y = pk2(f[2], f[3]); r.z = pk2(f[4], f[5]); r.w = pk2(f[6], f[7]); return r; }
#define MFMA32(a, b, c) __builtin_amdgcn_mfma_f32_32x32x16_bf16((a), (b), (c), 0, 0, 0)
DI u32x4 bload16(__amdgpu_buffer_rsrc_t rs, unsigned voff) { return __builtin_bit_cast(u32x4, __builtin_amdgcn_raw_buffer_load_b128(rs, (int)voff, 0, 0)); }
DI u32x4 bload16s(__amdgpu_buffer_rsrc_t rs, unsigned voff, unsigned soff) { return __builtin_bit_cast(u32x4, __builtin_amdgcn_raw_buffer_load_b128(rs, (int)voff, (int)soff, 0)); }
typedef short v4i16_t __attribute__((ext_vector_type(4)));
typedef __bf16 bf16x2_t __attribute__((ext_vector_type(2)));
DI unsigned pkbf(float lo, float hi) { typedef float f32x2_t __attribute__((ext_vector_type(2))); f32x2_t v = {lo, hi}; return __builtin_bit_cast(unsigned, __builtin_convertvector(v, bf16x2_t)); }

struct Args { const float* in[20]; float* out; unsigned char* ws; int ph_lo, ph_hi, probe, dry; };

namespace pg8 {
struct EpiIn {
    static constexpr bool PERM = true, AFTER_DRAIN = false;
    unsigned char* ws; bf16_t* GATE; const float *b_merge, *a_log, *dt_bias; int pn_off;
    __device__ __forceinline__ void operator()(const f32x4 (&acc)[2][2][4][2], const Unit& u, int wr, int wc, int fr, int fq) const {
        const int pn = u.pn + pn_off, row0 = u.pm * BM + wr * 64 + fr, cloc = wc * 32 + 8 * fq;
        {
            bf16_t* base; int ldc, colt, mode;
            if (pn < 6) { const int t = pn >> 1; base = (bf16_t*)(ws + WS_QA + (size_t)t * (WS_KA - WS_QA)); ldc = 512; colt = (pn & 1) * 256; mode = 0; }
            else if (pn < 18) { const int t = (pn - 6) >> 2; base = (bf16_t*)(ws + WS_QB + (size_t)t * (WS_KB - WS_QB)); ldc = 1024; colt = ((pn - 6) & 3) * 256; mode = 0; }
            else if (pn < 22) { base = GATE; ldc = 1024; colt = (pn - 18) * 256; mode = 1; }
            else { base = (bf16_t*)(ws + WS_MERGE); ldc = 2048; colt = (pn - 22) * 256; mode = 2; }
#pragma unroll
            for (int bj = 0; bj < 2; ++bj) {
                f32x4 b0 = (f32x4){0.f, 0.f, 0.f, 0.f}, b1 = b0;
                if (mode == 2) { b0 = *(const f32x4*)(b_merge + colt + bj * HALF + cloc); b1 = *(const f32x4*)(b_merge + colt + bj * HALF + cloc + 4); }
#pragma unroll
                for (int ai = 0; ai < 2; ++ai)
#pragma unroll
                    for (int m = 0; m < 4; ++m) {
                        f32x4 v0 = acc[ai][bj][m][0], v1 = acc[ai][bj][m][1];
                        if (mode == 1) {
#pragma unroll
                            for (int e = 0; e < 4; ++e) { v0[e] = v0[e] * __builtin_amdgcn_rcpf(1.0f + __builtin_amdgcn_exp2f(-1.4426950408889634f * v0[e])); v1[e] = v1[e] * __builtin_amdgcn_rcpf(1.0f + __builtin_amdgcn_exp2f(-1.4426950408889634f * v1[e])); }
                        } else if (mode == 2) {
#pragma unroll
                            for (int e = 0; e < 4; ++e) { v0[e] = __builtin_amdgcn_rcpf(1.0f + __builtin_amdgcn_exp2f(-1.4426950408889634f * (v0[e] + b0[e]))); v1[e] = __builtin_amdgcn_rcpf(1.0f + __builtin_amdgcn_exp2f(-1.4426950408889634f * (v1[e] + b1[e]))); }
                        }
                        if (mode == 2) {
                            unsigned g0 = 0u, g1 = 0u;
                            g0 = __builtin_amdgcn_cvt_pk_u8_f32(v0[0] * 255.0f + 0.5f, 0, g0); g0 = __builtin_amdgcn_cvt_pk_u8_f32(v0[1] * 255.0f + 0.5f, 1, g0); g0 = __builtin_amdgcn_cvt_pk_u8_f32(v0[2] * 255.0f + 0.5f, 2, g0); g0 = __builtin_amdgcn_cvt_pk_u8_f32(v0[3] * 255.0f + 0.5f, 3, g0);
                            g1 = __builtin_amdgcn_cvt_pk_u8_f32(v1[0] * 255.0f + 0.5f, 0, g1); g1 = __builtin_amdgcn_cvt_pk_u8_f32(v1[1] * 255.0f + 0.5f, 1, g1); g1 = __builtin_amdgcn_cvt_pk_u8_f32(v1[2] * 255.0f + 0.5f, 2, g1); g1 = __builtin_amdgcn_cvt_pk_u8_f32(v1[3] * 255.0f + 0.5f, 3, g1);
                            *(u32x2*)((unsigned char*)base + (size_t)(row0 + ai * HALF + m * 16) * 2048 + colt + bj * HALF + cloc) = (u32x2){g0, g1};
                        } else {
                        u32x4 w; w.x = cvt_pk_bf16(v0[0], v0[1]); w.y = cvt_pk_bf16(v0[2], v0[3]); w.z = cvt_pk_bf16(v1[0], v1[1]); w.w = cvt_pk_bf16(v1[2], v1[3]);
                        *(u32x4*)(base + (size_t)(row0 + ai * HALF + m * 16) * ldc + colt + bj * HALF + cloc) = w; }
                    }
            }
        }
    }
};
template <bool SECOND> struct EpiMix {
    static constexpr bool PERM = true, AFTER_DRAIN = false;
    bf16_t* MIXED; const unsigned char* GATES; const bf16_t* PART;
    __device__ __forceinline__ void operator()(const f32x4 (&acc)[2][2][4][2], const Unit& u, int wr, int wc, int fr, int fq) const {
        const int row0 = u.pm * BM + wr * 64 + fr, col0 = u.pn * BM + wc * 32 + 8 * fq;
#pragma unroll
        for (int ai = 0; ai < 2; ++ai)
#pragma unroll
            for (int m = 0; m < 4; ++m)
#pragma unroll
                for (int bj = 0; bj < 2; ++bj) {
                    const size_t row = (size_t)(row0 + ai * HALF + m * 16); const int col = col0 + bj * HALF;
                    const u32x2 g = *(const u32x2*)(GATES + row * 2048 + col);
                    float gv[8];
#pragma unroll
                    for (int e = 0; e < 4; ++e) { gv[e] = (float)((g.x >> (8 * e)) & 255u) * (1.0f / 255.0f); gv[4 + e] = (float)((g.y >> (8 * e)) & 255u) * (1.0f / 255.0f); }
                    const f32x4 a0 = acc[ai][bj][m][0], a1 = acc[ai][bj][m][1];
                    float o[8];
#pragma unroll
                    for (int e = 0; e < 4; ++e) { o[e] = a0[e] * gv[e]; o[4 + e] = a1[e] * gv[4 + e]; }
                    bf16_t* dst = MIXED + row * 1024 + col;
                    if (SECOND) { const u32x4 p = *(const u32x4*)(PART + row * 1024 + col);
                        o[0] += __builtin_bit_cast(float, p.x << 16); o[1] += __builtin_bit_cast(float, p.x & 0xffff0000u); o[2] += __builtin_bit_cast(float, p.y << 16); o[3] += __builtin_bit_cast(float, p.y & 0xffff0000u);
                        o[4] += __builtin_bit_cast(float, p.z << 16); o[5] += __builtin_bit_cast(float, p.z & 0xffff0000u); o[6] += __builtin_bit_cast(float, p.w << 16); o[7] += __builtin_bit_cast(float, p.w & 0xffff0000u); }
                    u32x4 w; w.x = cvt_pk_bf16(o[0], o[1]); w.y = cvt_pk_bf16(o[2], o[3]); w.z = cvt_pk_bf16(o[4], o[5]); w.w = cvt_pk_bf16(o[6], o[7]);
                    *(u32x4*)dst = w;
                }
    }
};
struct EpiOut {
    static constexpr bool PERM = false, AFTER_DRAIN = false;
    const float* X; float* OUT; bf16_t* X2B; float* SSQ;
    __device__ __forceinline__ void operator()(const f32x4 (&acc)[2][2][4][2], const Unit& u, int wr, int wc, int fr, int fq) const {
        const int row0 = u.pm * BM + wr * 64 + fr, col0 = u.pn * BM + wc * 32 + 4 * fq;
#pragma unroll
        for (int ai = 0; ai < 2; ++ai)
#pragma unroll
            for (int m = 0; m < 4; ++m) {
                const size_t row = (size_t)(row0 + ai * HALF + m * 16); float ss = 0.f;
#pragma unroll
                for (int bj = 0; bj < 2; ++bj)
#pragma unroll
                    for (int n = 0; n < 2; ++n) {
                        const size_t off = row * 1024 + col0 + bj * HALF + n * 16;
                        const f32x4 o = *(const f32x4*)(X + off) + acc[ai][bj][m][n];
                        ss += (o[0] * o[0] + o[1] * o[1]) + (o[2] * o[2] + o[3] * o[3]);
                        unsigned lo = cvt_pk_bf16(o[0], o[1]), hi = cvt_pk_bf16(o[2], o[3]);
                        *(unsigned long long*)(X2B + off) = (unsigned long long)lo | ((unsigned long long)hi << 32);
                    }
                ss += __shfl_xor(ss, 16); ss += __shfl_xor(ss, 32);
                if (fq == 0) SSQ[row * 16 + u.pn * 4 + wc] = ss;
            }
    }
};
struct RowTileOrder {
    int pm, nN;
    __device__ __forceinline__ bool next(int i, Unit& u) const { if (i >= nN) return false; u.pm = pm; u.pn = i; return true; }
    __device__ __forceinline__ void a_ready(const Unit&) const {}
    __device__ __forceinline__ void done(const Unit&) const {}
};
struct EpiPlain {
    static constexpr bool PERM = true, AFTER_DRAIN = false;
    bf16_t* O; int ldc;
    __device__ __forceinline__ void operator()(const f32x4 (&acc)[2][2][4][2], const Unit& u, int wr, int wc, int fr, int fq) const {
        const int row0 = u.pm * BM + wr * 64 + fr, col0 = u.pn * BM + wc * 32 + 8 * fq;
#pragma unroll
        for (int ai = 0; ai < 2; ++ai)
#pragma unroll
            for (int m = 0; m < 4; ++m)
#pragma unroll
                for (int bj = 0; bj < 2; ++bj) {
                    const f32x4 v0 = acc[ai][bj][m][0], v1 = acc[ai][bj][m][1];
                    u32x4 w; w.x = cvt_pk_bf16(v0[0], v0[1]); w.y = cvt_pk_bf16(v0[2], v0[3]); w.z = cvt_pk_bf16(v1[0], v1[1]); w.w = cvt_pk_bf16(v1[2], v1[3]);
                    *(u32x4*)(O + (size_t)(row0 + ai * HALF + m * 16) * ldc + col0 + bj * HALF) = w;
                }
    }
};
struct EpiScore {
    static constexpr bool PERM = true, AFTER_DRAIN = false;
    bf16_t* O; const float* XSC; const float* WKSC;
    __device__ __forceinline__ void operator()(const f32x4 (&acc)[2][2][4][2], const Unit& u, int wr, int wc, int fr, int fq) const {
        const int row0 = u.pm * BM + wr * 64 + fr, col0 = u.pn * BM + wc * 32 + 8 * fq;
        f32x4 cs[2][2];
#pragma unroll
        for (int bj = 0; bj < 2; ++bj) { cs[bj][0] = *(const f32x4*)(WKSC + col0 + bj * HALF); cs[bj][1] = *(const f32x4*)(WKSC + col0 + bj * HALF + 4); }
#pragma unroll
        for (int ai = 0; ai < 2; ++ai)
#pragma unroll
            for (int m = 0; m < 4; ++m) {
                const float rs = XSC[row0 + ai * HALF + m * 16];
#pragma unroll
                for (int bj = 0; bj < 2; ++bj) {
                    const v4i_t v0 = __builtin_bit_cast(v4i_t, acc[ai][bj][m][0]), v1 = __builtin_bit_cast(v4i_t, acc[ai][bj][m][1]);
                    float o[8];
#pragma unroll
                    for (int e = 0; e < 4; ++e) { o[e] = (float)v0[e] * rs * cs[bj][0][e]; o[4 + e] = (float)v1[e] * rs * cs[bj][1][e]; }
                    u32x4 w; w.x = cvt_pk_bf16(o[0], o[1]); w.y = cvt_pk_bf16(o[2], o[3]); w.z = cvt_pk_bf16(o[4], o[5]); w.w = cvt_pk_bf16(o[6], o[7]);
                    *(u32x4*)(O + (size_t)(row0 + ai * HALF + m * 16) * 2048 + col0 + bj * HALF) = w;
                }
            }
    }
};
}

template <int MODE> DI void p0_transpose_item(const float* W, int ldw, bf16* WT, int ldk, int nblk, const float* sc, LAS float* scr, int item, int lane) {
    const int kb = item / nblk, nb = item % nblk, k0 = 64 * kb, n0 = 32 * nb;
    const int nn = n0 + (lane & 31); int src = nn; bool valid = true;
    if (MODE == 1) { if (nn < 4608) src = nn; else if (nn < 7680) src = nn + 16; else if (nn < 7696) src = nn - 7680 + 4608; else { valid = false; src = 0; } }
#pragma unroll 8
    for (int i = 0; i < 32; ++i) { const int kk = 2 * i + (lane >> 5); float v = W[(size_t)(k0 + kk) * ldw + src]; if (!valid) v = 0.f; if (MODE == 2) v *= sc[k0 + kk]; scr[kk * 33 + (lane & 31)] = v; }
    asm volatile("s_waitcnt lgkmcnt(0)" ::: "memory");
    const int c = lane & 7;
#pragma unroll
    for (int j = 0; j < 4; ++j) { const int n = (lane >> 3) + 8 * j; const LAS float* s = scr + (8 * c) * 33 + n;
        u32x4 o; o.x = pk2(s[0 * 33], s[1 * 33]); o.y = pk2(s[2 * 33], s[3 * 33]); o.z = pk2(s[4 * 33], s[5 * 33]); o.w = pk2(s[6 * 33], s[7 * 33]);
        *(u32x4*)(WT + (size_t)(n0 + n) * ldk + k0 + 8 * c) = o; }
    asm volatile("s_waitcnt lgkmcnt(0)" ::: "memory");
}
DI void p0_transpose_item_fp8(const float* W, int ldw, unsigned char* WT8, int ldk, int nblk, LAS float* scr, int item, int lane) {
    const int kb = item / nblk, nb = item % nblk, k0 = 64 * kb, n0 = 32 * nb;
    const int nn = n0 + (lane & 31); int src = nn; bool valid = true;
    { if (nn < 4608) src = nn; else if (nn < 7680) src = nn + 16; else if (nn < 7696) src = nn - 7680 + 4608; else { valid = false; src = 0; } }
#pragma unroll 8
    for (int i = 0; i < 32; ++i) { const int kk = 2 * i + (lane >> 5); float v = W[(size_t)(k0 + kk) * ldw + src]; if (!valid) v = 0.f; scr[kk * 33 + (lane & 31)] = v * 256.0f; }
    asm volatile("s_waitcnt lgkmcnt(0)" ::: "memory");
    const int c = lane & 7;
#pragma unroll
    for (int j = 0; j < 4; ++j) { const int n = (lane >> 3) + 8 * j; const LAS float* s = scr + (8 * c) * 33 + n;
        int w0 = __builtin_amdgcn_cvt_pk_fp8_f32(s[0 * 33], s[1 * 33], 0, false); w0 = __builtin_amdgcn_cvt_pk_fp8_f32(s[2 * 33], s[3 * 33], w0, true);
        int w1 = __builtin_amdgcn_cvt_pk_fp8_f32(s[4 * 33], s[5 * 33], 0, false); w1 = __builtin_amdgcn_cvt_pk_fp8_f32(s[6 * 33], s[7 * 33], w1, true);
        *(u32x2*)(WT8 + (size_t)(n0 + n) * ldk + k0 + 8 * c) = (u32x2){(unsigned)w0, (unsigned)w1}; }
    asm volatile("s_waitcnt lgkmcnt(0)" ::: "memory");
}
DI void rms_row_to_bf16(const float* xrow, const float* w, bf16* orow, int lane) {
    const f32x4* xr = (const f32x4*)xrow + lane; const f32x4* wr = (const f32x4*)w + lane;
    f32x4 v[4]; float s = 0.f;
#pragma unroll
    for (int j = 0; j < 4; ++j) { v[j] = xr[64 * j]; s += (v[j].x * v[j].x + v[j].y * v[j].y) + (v[j].z * v[j].z + v[j].w * v[j].w); }
    const float rstd = 1.0f / sqrtf(wave_sum(s) * (1.0f / DM) + EPS);
    unsigned long long* o8 = (unsigned long long*)orow + lane;
#pragma unroll
    for (int j = 0; j < 4; ++j) { const f32x4 ww = wr[64 * j]; const f32x4 o = v[j] * rstd * ww; o8[64 * j] = (unsigned long long)pk2(o.x, o.y) | ((unsigned long long)pk2(o.z, o.w) << 32); }
}

DI void wk_tile(const Args& a, int job, int lane) {
    const int r32 = lane & 31, hi = lane >> 5;
    const int blk = job >> 7, h = blk >> 1, p = blk & 1, kt = (job & 127) >> 5, jt = job & 31;
    const float* kp = (p == 0 ? a.in[16] : a.in[17]) + ((size_t)(h * 128 + kt * 32 + r32)) * 128 + 8 * hi;
    const int j = jt * 32 + r32; const float* wp = a.in[15] + (size_t)j * 2048 + h * 256 + p * 128 + 8 * hi; const float wn = a.in[14][j];
    f32x16 acc;
#pragma unroll
    for (int r = 0; r < 16; ++r) acc[r] = 0.f;
#pragma unroll
    for (int s = 0; s < 8; ++s) {
        const f32x4 k0 = *(const f32x4*)(kp + 16 * s), k1 = *(const f32x4*)(kp + 16 * s + 4), w0 = *(const f32x4*)(wp + 16 * s) * wn, w1 = *(const f32x4*)(wp + 16 * s + 4) * wn;
        u32x4 ka, wb; ka.x = pkbf(k0.x, k0.y); ka.y = pkbf(k0.z, k0.w); ka.z = pkbf(k1.x, k1.y); ka.w = pkbf(k1.z, k1.w); wb.x = pkbf(w0.x, w0.y); wb.y = pkbf(w0.z, w0.w); wb.z = pkbf(w1.x, w1.y); wb.w = pkbf(w1.z, w1.w);
        acc = MFMA32(__builtin_bit_cast(bf16x8, ka), __builtin_bit_cast(bf16x8, wb), acc); }
    bf16* dst = (bf16*)(a.ws + WS_WQ) + ((size_t)(blk * 128 + kt * 32)) * 1024 + j;
#pragma unroll
    for (int r = 0; r < 16; ++r) dst[(size_t)crow(r, hi) * 1024] = (bf16)(pkbf(acc[r], 0.f) & 0xffffu);
}
typedef float f32x4m __attribute__((ext_vector_type(4)));
DI void phase0(const Args& a, LAS unsigned char* lds, int gw, int NGW, int wave, int lane) {
    unsigned char* ws = a.ws;
    LAS float* scr = (LAS float*)(lds + wave * 16384);
    constexpr int I_IN = 16 * (NIN / 32), I_PA = 8 * 32, I_PB = 16 * 32, I_OUT = 16 * 32, I_Q = 16 * 4 * 32;
    constexpr int NITEMS = I_IN + I_PA + I_PB + I_OUT + I_Q;
    for (int it = gw; it < NITEMS; it += NGW) {
        int r = it;
#if P1_FP8
        if (r < I_IN) { const int nb_ = r % (NIN / 32); if (nb_ >= P1_FP8_UPTO / 32) { }
                        else p0_transpose_item_fp8(a.in[2], 7696, ws + WS_W8, 1024, NIN / 32, scr, r, lane); continue; } r -= I_IN;
#else
        if (r < I_IN) { p0_transpose_item<1>(a.in[2], 7696, (bf16*)(ws + WS_WIN), 1024, NIN / 32, nullptr, scr, r, lane); continue; } r -= I_IN;
#endif
        if (r < I_PA) { p0_transpose_item<0>(a.in[11], 1024, (bf16*)(ws + WS_WPA), 512, 32, nullptr, scr, r, lane); continue; } r -= I_PA;
        if (r < I_PB) { p0_transpose_item<0>(a.in[12], 1024, (bf16*)(ws + WS_WPB), 1024, 32, nullptr, scr, r, lane); continue; } r -= I_PB;
        if (r < I_OUT) { p0_transpose_item<0>(a.in[13], 1024, (bf16*)(ws + WS_WOUT), 1024, 32, nullptr, scr, r, lane); continue; } r -= I_OUT;
        wk_tile(a, r, lane);
    }
    static_assert(P1_FP8 && P1_FP8_UPTO == 7680, "the fused a|beta path assumes the all-fp8 input projection");
    __syncthreads();
    { LAS bf16* wab = (LAS bf16*)lds; const int t = wave * 64 + lane;
#pragma unroll
      for (int kk = 0; kk < 2; ++kk) { const int k = t + 512 * kk; const f32x4* src = (const f32x4*)(a.in[2] + (size_t)k * 7696 + 4608);
#pragma unroll
          for (int q = 0; q < 4; ++q) { const f32x4 w4 = src[q]; const unsigned p01 = pkbf(w4.x, w4.y), p23 = pkbf(w4.z, w4.w);
              LAS unsigned short* d = (LAS unsigned short*)wab + k;
              d[(4 * q + 0) * 1032] = (unsigned short)(p01 & 0xffffu); d[(4 * q + 1) * 1032] = (unsigned short)(p01 >> 16); d[(4 * q + 2) * 1032] = (unsigned short)(p23 & 0xffffu); d[(4 * q + 3) * 1032] = (unsigned short)(p23 >> 16); } } }
    __syncthreads();
    { f32x4 wv[4];
      const LAS bf16* wab = (const LAS bf16*)lds; LAS bf16* ht = (LAS bf16*)(lds + 33280 + wave * 8256);
      const int fr = lane & 15, fq = lane >> 4; const int hcol = fr & 7; const float al = -__expf(a.in[7][hcol]), db = a.in[8][hcol];
#pragma unroll
      for (int j = 0; j < 4; ++j) wv[j] = ((const f32x4*)a.in[1])[lane + 64 * j];
      for (int m0 = gw * 4; m0 < M; m0 += NGW * 4) {
        f32x4 v[4][4];
#pragma unroll
        for (int q = 0; q < 4; ++q) { const f32x4* xr = (const f32x4*)(a.in[0] + (size_t)(m0 + q) * DM) + lane;
#pragma unroll
            for (int j = 0; j < 4; ++j) v[q][j] = xr[64 * j]; }
#pragma unroll
        for (int q = 0; q < 4; ++q) { float ssq = 0.f;
#pragma unroll
            for (int j = 0; j < 4; ++j) ssq += (v[q][j].x * v[q][j].x + v[q][j].y * v[q][j].y) + (v[q][j].z * v[q][j].z + v[q][j].w * v[q][j].w);
            const float rstd = 1.0f / sqrtf(wave_sum(ssq) * (1.0f / DM) + EPS);
#pragma unroll
            for (int j = 0; j < 4; ++j) { const f32x4 o = v[q][j] * rstd * wv[j];
                *(LAS u32x2*)(ht + q * 1032 + 4 * (lane + 64 * j)) = (u32x2){pkbf(o.x, o.y), pkbf(o.z, o.w)};
                int w8 = __builtin_amdgcn_cvt_pk_fp8_f32(o.x, o.y, 0, false); w8 = __builtin_amdgcn_cvt_pk_fp8_f32(o.z, o.w, w8, true); ((unsigned*)(ws + WS_H8 + (size_t)(m0 + q) * DM))[lane + 64 * j] = (unsigned)w8;
            } }
        asm volatile("s_waitcnt lgkmcnt(0)" ::: "memory");
        f32x4m acc0 = {0.f, 0.f, 0.f, 0.f}, acc1 = {0.f, 0.f, 0.f, 0.f};
        const LAS bf16* ap = ht + (fr & 3) * 1032 + 8 * fq; const LAS bf16* bp = wab + fr * 1032 + 8 * fq;
#pragma unroll 8
        for (int s2 = 0; s2 < 32; s2 += 2) {
            u32x4 a0 = *(const LAS u32x4*)(ap + 32 * s2), a1 = *(const LAS u32x4*)(ap + 32 * s2 + 32);
            if (fr >= 4) { a0 = (u32x4){0u, 0u, 0u, 0u}; a1 = a0; }
            acc0 = __builtin_amdgcn_mfma_f32_16x16x32_bf16(__builtin_bit_cast(bf16x8, a0), *(const LAS bf16x8*)(bp + 32 * s2), acc0, 0, 0, 0);
            acc1 = __builtin_amdgcn_mfma_f32_16x16x32_bf16(__builtin_bit_cast(bf16x8, a1), *(const LAS bf16x8*)(bp + 32 * s2 + 32), acc1, 0, 0, 0); }
        if (fq == 0) {
#pragma unroll
            for (int i = 0; i < 4; ++i) { float z = (i == 0 ? acc0.x + acc1.x : i == 1 ? acc0.y + acc1.y : i == 2 ? acc0.z + acc1.z : acc0.w + acc1.w);
                if (fr < 8) { const float x = z + db; z = al * (fmaxf(x, 0.f) + log1pf(__expf(-fabsf(x)))); } else z = 1.0f / (1.0f + __expf(-z));
                ((float*)(ws + WS_AB))[(size_t)(m0 + i) * 16 + fr] = z; } }
      } }
}


DI void ab_rows(const Args& a, int bx, int wave, int lane) {
    const int fr = lane & 15, fq = lane >> 4, row0 = 128 * bx + 16 * wave;
    const bf16* Ap = (const bf16*)a.out + (size_t)(row0 + fr) * 1024 + 8 * fq;
    const bf16* Bp = (const bf16*)(a.ws + WS_WIN) + (size_t)(7680 + fr) * 1024 + 8 * fq;
    f32x4m acc = {0.f, 0.f, 0.f, 0.f};
#pragma unroll 8
    for (int s = 0; s < 32; ++s) { const bf16x8 af = *(const bf16x8*)(Ap + 32 * s), bfr = *(const bf16x8*)(Bp + 32 * s); acc = __builtin_amdgcn_mfma_f32_16x16x32_bf16(af, bfr, acc, 0, 0, 0); }
    const int hcol = fr & 7; const float al = a.in[7][hcol], db = a.in[8][hcol];
#pragma unroll
    for (int i = 0; i < 4; ++i) { float v = acc[i];
        if (fr < 8) { const float x = v + db; v = -__expf(al) * (fmaxf(x, 0.f) + log1pf(__expf(-fabsf(x)))); } else v = 1.0f / (1.0f + __expf(-v));
        ((float*)(a.ws + WS_AB))[(size_t)(row0 + 4 * fq + i) * 16 + fr] = v; }
}
DI bf16x8 pack_frag(const f32x16& x, int s) {
    u32x4 p; p.x = pg8::cvt_pk_bf16(x[8 * s + 0], x[8 * s + 1]); p.y = pg8::cvt_pk_bf16(x[8 * s + 2], x[8 * s + 3]); p.z = pg8::cvt_pk_bf16(x[8 * s + 4], x[8 * s + 5]); p.w = pg8::cvt_pk_bf16(x[8 * s + 6], x[8 * s + 7]);
    return __builtin_bit_cast(bf16x8, p);
}
DI float sumsq8(const u32x4 r) { float f[8]; unpack8(r, f); float s = 0.f;
#pragma unroll
    for (int j = 0; j < 8; ++j) s += f[j] * f[j];
    return s; }
DI void attn_unit(const Args& a, int b, int n, LAS unsigned char* wl, int head, int lane, bool dry) {
    const int r32 = lane & 31, hi = lane >> 5;
    LAS bf16* vt = (LAS bf16*)wl;
    LAS float* bias = (LAS float*)(wl + 9216);
    LAS u32x4* qfl = (LAS u32x4*)(wl + 9216 + 768);
    LAS float* rkl = (LAS float*)(wl + 9216 + 768 + 8192);
    unsigned char* ws = a.ws;
    bf16* QA = (bf16*)(ws + WS_QA); const bf16* KA = (const bf16*)(ws + WS_KA); const bf16* VA = (const bf16*)(ws + WS_VA);
    for (int i = lane; i < 192; i += 64) bias[i] = a.in[5][head * 257 + 65 + i];
    bf16* Qp = QA + ((size_t)(b * SEQ + n * 64)) * 512 + head * 64;
#pragma unroll
    for (int qh = 0; qh < 2; ++qh) {
        u32x4 raw[4]; float ss = 0.f;
#pragma unroll
        for (int s = 0; s < 4; ++s) { raw[s] = *(const u32x4*)(Qp + (size_t)(qh * 32 + r32) * 512 + 16 * s + 8 * hi); ss += sumsq8(raw[s]); }
        ss += __shfl_xor(ss, 32);
        const float rstd = 0.125f / sqrtf(ss * (1.0f / 64.0f) + EPS);
#pragma unroll
        for (int s = 0; s < 4; ++s) { float f[8]; unpack8(raw[s], f);
#pragma unroll
            for (int j = 0; j < 8; ++j) { const int d = 16 * s + 8 * hi + j; f[j] *= rstd * a.in[3][d] * a.in[4][d]; }
            qfl[(qh * 4 + s) * 64 + lane] = pack8(f); }
    }
    float mrun[2] = {-1e30f, -1e30f}, lrun[2] = {0.f, 0.f};
    f32x16 o[2][2];
#pragma unroll
    for (int d = 0; d < 2; ++d)
#pragma unroll
        for (int q = 0; q < 2; ++q)
#pragma unroll
            for (int r = 0; r < 16; ++r) o[d][q][r] = 0.f;
    const int jb0 = (n >= 8) ? 0 : 8 - n;
    u32x4 kraw[2][4], vraw[8];
    const __amdgpu_buffer_rsrc_t rsK = __builtin_amdgcn_make_buffer_rsrc((void*)(ws + WS_KA), (short)0, (int)(32 * MiB), 0x00020000), rsV = __builtin_amdgcn_make_buffer_rsrc((void*)(ws + WS_VA), (short)0, (int)(32 * MiB), 0x00020000);
    const unsigned kvo = (unsigned)(r32 * 512 + 8 * hi) * 2u, vvo = (unsigned)((lane >> 3) * 512 + (lane & 7) * 8) * 2u;
#define ATT_LOADK(jbx) do { const unsigned so_ = (unsigned)(((b * SEQ + (n + (jbx) - 8) * 64) * 512 + head * 64) * 2); \
        _Pragma("unroll") for (int kb = 0; kb < 2; ++kb) _Pragma("unroll") for (int s = 0; s < 4; ++s) kraw[kb][s] = bload16s(rsK, kvo, so_ + (unsigned)((kb * 32 * 512 + 16 * s) * 2)); } while (0)
#define ATT_LOADV(jbx) do { const unsigned so_ = (unsigned)(((b * SEQ + (n + (jbx) - 8) * 64) * 512 + head * 64) * 2); \
        _Pragma("unroll") for (int it = 0; it < 8; ++it) vraw[it] = bload16s(rsV, vvo, so_ + (unsigned)(it * 8 * 512 * 2)); } while (0)
    ATT_LOADK(jb0); ATT_LOADV(jb0);
    for (int jb = jb0; jb <= 8; ++jb) {
        asm volatile("s_waitcnt lgkmcnt(0)" ::: "memory");
#pragma unroll
        for (int it = 0; it < 8; ++it) *(LAS u32x4*)(vt + (it * 8 + (lane >> 3)) * 72 + (lane & 7) * 8) = vraw[it];
        if (jb < 8) ATT_LOADV(jb + 1);
        bf16x8 kf[2][4]; float rk[2];
#pragma unroll
        for (int kb = 0; kb < 2; ++kb) { float ss = 0.f;
#pragma unroll
            for (int s = 0; s < 4; ++s) { kf[kb][s] = __builtin_bit_cast(bf16x8, kraw[kb][s]); ss += sumsq8(kraw[kb][s]); }
            ss += __shfl_xor(ss, 32); rk[kb] = 1.0f / sqrtf(ss * (1.0f / 64.0f) + EPS); if (hi == 0) rkl[kb * 32 + r32] = rk[kb]; }
        f32x16 p[2][2];
#pragma unroll
        for (int kb = 0; kb < 2; ++kb)
#pragma unroll
            for (int qh = 0; qh < 2; ++qh) {
#pragma unroll
                for (int r = 0; r < 16; ++r) p[kb][qh][r] = 0.f;
#pragma unroll
                for (int s = 0; s < 4; ++s) p[kb][qh] = MFMA32(kf[kb][s], __builtin_bit_cast(bf16x8, qfl[(qh * 4 + s) * 64 + lane]), p[kb][qh]);
            }
        if (jb < 8) ATT_LOADK(jb + 1);
#pragma unroll
        for (int kb = 0; kb < 2; ++kb)
#pragma unroll
            for (int r = 0; r < 16; ++r) {
                const int kr = crow(r, hi); const float rs = (*(const LAS f32x4*)(rkl + kb * 32 + 8 * (r >> 2) + 4 * hi))[r & 3];
                const int j = jb * 64 + kb * 32 + kr;
#pragma unroll
                for (int qh = 0; qh < 2; ++qh) { int rel = 512 + qh * 32 + r32 - j; rel = rel < -128 ? -128 : (rel > 128 ? 128 : rel);
                    p[kb][qh][r] = p[kb][qh][r] * rs + bias[rel + 63]; }
            }
#pragma unroll
        for (int qh = 0; qh < 2; ++qh) {
            float mx = -1e30f;
#pragma unroll
            for (int kb = 0; kb < 2; ++kb)
#pragma unroll
                for (int r = 0; r < 16; ++r) mx = fmaxf(mx, p[kb][qh][r]);
            mx = fmaxf(mx, __shfl_xor(mx, 32));
            const float mnew = fmaxf(mrun[qh], mx), alpha = __expf(mrun[qh] - mnew);
            float sum = 0.f;
#pragma unroll
            for (int kb = 0; kb < 2; ++kb)
#pragma unroll
                for (int r = 0; r < 16; ++r) { const float e = __expf(p[kb][qh][r] - mnew); p[kb][qh][r] = e; sum += e; }
            sum += __shfl_xor(sum, 32);
            lrun[qh] = lrun[qh] * alpha + sum; mrun[qh] = mnew;
#pragma unroll
            for (int d = 0; d < 2; ++d)
#pragma unroll
                for (int r = 0; r < 16; ++r) o[d][qh][r] *= alpha;
        }
        asm volatile("s_waitcnt lgkmcnt(0)" ::: "memory");
#pragma unroll
        for (int kb = 0; kb < 2; ++kb)
#pragma unroll
            for (int s2 = 0; s2 < 2; ++s2) {
                bf16x8 af[2];
#pragma unroll
                for (int d = 0; d < 2; ++d) {
                    const LAS bf16* rp = vt + (kb * 32 + 16 * s2 + 4 * hi + ((lane & 15) >> 2)) * 72 + d * 32 + 16 * ((lane >> 4) & 1) + 4 * (lane & 3);
                    const v4i16_t lo = __builtin_amdgcn_ds_read_tr16_b64_v4i16((LAS v4i16_t*)rp), hi2 = __builtin_amdgcn_ds_read_tr16_b64_v4i16((LAS v4i16_t*)(rp + 8 * 72));
                    af[d] = (bf16x8){lo[0], lo[1], lo[2], lo[3], hi2[0], hi2[1], hi2[2], hi2[3]}; }
#pragma unroll
                for (int qh = 0; qh < 2; ++qh) { const bf16x8 bfq = pack_frag(p[kb][qh], s2);
#pragma unroll
                    for (int d = 0; d < 2; ++d) o[d][qh] = MFMA32(af[d], bfq, o[d][qh]); }
            }
    }
#undef ATT_LOADK
#undef ATT_LOADV
    if (!dry) {
#pragma unroll
    for (int qh = 0; qh < 2; ++qh) { const float inv = 1.0f / lrun[qh];
#pragma unroll
        for (int d = 0; d < 2; ++d)
#pragma unroll
            for (int r = 0; r < 16; ++r) Qp[(size_t)(qh * 32 + r32) * 512 + d * 32 + crow(r, hi)] = (bf16)(pkbf(o[d][qh][r] * inv, 0.f) & 0xffffu);
    }
    }
}

DI void gdn_seq(const Args& a, int bh, LAS unsigned char* lds, int tid) {
    const int b = bh >> 3, h = bh & 7;
    unsigned char* ws = a.ws;
    LAS float* qs = (LAS float*)lds; LAS float* ks = qs + 64 * 128; LAS float* vs = ks + 64 * 128; LAS float* os = vs + 64 * 128;
    LAS float* eg = os + 64 * 128; LAS float* be = eg + 64;
    const float* AB = (const float*)(ws + WS_AB);
    const bf16* GATE = (const bf16*)a.out + (size_t)M * DM;
    bf16* OB = (bf16*)(ws + WS_OB);
    const int tens = tid >> 7, rb = (tid & 127) >> 4, seg = tid & 15;
    float cw[4][8];
#pragma unroll
    for (int i = 0; i < 4; ++i)
#pragma unroll
        for (int j = 0; j < 8; ++j) cw[i][j] = (tid < 384) ? a.in[6][(size_t)i * 3072 + tens * 1024 + h * 128 + seg * 8 + j] : 0.f;
    const bf16* srcT = (const bf16*)(ws + WS_QB + (size_t)(tens > 2 ? 2 : tens) * (WS_KB - WS_QB));
    LAS float* dstT = qs + (tens > 2 ? 2 : tens) * (64 * 128);
    const int dv = tid >> 2, part = tid & 3;
    float S[32];
#pragma unroll
    for (int i = 0; i < 32; ++i) S[i] = 0.f;
    for (int n = 0; n < 32; ++n) {
        if (tid < 384) {
            float x[11][8];
#pragma unroll
            for (int i = 0; i < 11; ++i) { const int tpos = n * 64 + rb * 8 - 3 + i;
                if (tpos >= 0) { const u32x4 raw = *(const u32x4*)(srcT + ((size_t)(b * SEQ + tpos)) * 1024 + h * 128 + seg * 8); unpack8(raw, x[i]); }
                else {
#pragma unroll
                    for (int j = 0; j < 8; ++j) x[i][j] = 0.f; } }
#pragma unroll
            for (int r = 0; r < 8; ++r) { float y[8]; float ss = 0.f;
#pragma unroll
                for (int j = 0; j < 8; ++j) { float v = cw[0][j] * x[r][j] + cw[1][j] * x[r + 1][j] + cw[2][j] * x[r + 2][j] + cw[3][j] * x[r + 3][j]; v = v / (1.0f + __expf(-v)); y[j] = v; ss += v * v; }
                if (tens < 2) { ss += __shfl_xor(ss, 1); ss += __shfl_xor(ss, 2); ss += __shfl_xor(ss, 4); ss += __shfl_xor(ss, 8);
                    const float sc = (tens == 0 ? 0.08838834764831845f : 1.0f) / sqrtf(ss + EPS);
#pragma unroll
                    for (int j = 0; j < 8; ++j) y[j] *= sc; }
                LAS float* d = dstT + (rb * 8 + r) * 128 + seg * 8;
                *(LAS f32x4*)d = (f32x4){y[0], y[1], y[2], y[3]}; *(LAS f32x4*)(d + 4) = (f32x4){y[4], y[5], y[6], y[7]}; }
        } else if (tid < 448) { const int t = tid - 384; const size_t row = (size_t)(b * SEQ + n * 64 + t);
            eg[t] = __expf(AB[row * 16 + h]); be[t] = AB[row * 16 + 8 + h]; }
        __syncthreads();
        for (int t = 0; t < 64; ++t) {
            const LAS f32x4* kp = (const LAS f32x4*)(ks + t * 128 + part * 32); const LAS f32x4* qp = (const LAS f32x4*)(qs + t * 128 + part * 32);
            f32x4 kv[8]; float kS0 = 0.f, kS1 = 0.f;
#pragma unroll
            for (int i = 0; i < 8; ++i) { kv[i] = kp[i]; kS0 += kv[i].x * S[4 * i] + kv[i].y * S[4 * i + 1]; kS1 += kv[i].z * S[4 * i + 2] + kv[i].w * S[4 * i + 3]; }
            float kS = kS0 + kS1; kS += __shfl_xor(kS, 1); kS += __shfl_xor(kS, 2);
            const float e = eg[t], c = be[t] * (vs[t * 128 + dv] - e * kS);
            float o0 = 0.f, o1 = 0.f;
#pragma unroll
            for (int i = 0; i < 8; ++i) { const f32x4 qv = qp[i];
                S[4 * i] = e * S[4 * i] + kv[i].x * c; S[4 * i + 1] = e * S[4 * i + 1] + kv[i].y * c; S[4 * i + 2] = e * S[4 * i + 2] + kv[i].z * c; S[4 * i + 3] = e * S[4 * i + 3] + kv[i].w * c;
                o0 += qv.x * S[4 * i] + qv.y * S[4 * i + 1]; o1 += qv.z * S[4 * i + 2] + qv.w * S[4 * i + 3]; }
            float ov = o0 + o1; ov += __shfl_xor(ov, 1); ov += __shfl_xor(ov, 2);
            if (part == 0) os[t * 128 + dv] = ov;
        }
        __syncthreads();
#pragma unroll
        for (int it = 0; it < 2; ++it) { const int item = tid + 512 * it, row = item >> 4, sg = item & 15;
            const LAS float* op = os + row * 128 + sg * 8; const f32x4 o0 = *(const LAS f32x4*)op, o1 = *(const LAS f32x4*)(op + 4);
            float ss = (o0.x * o0.x + o0.y * o0.y) + (o0.z * o0.z + o0.w * o0.w) + (o1.x * o1.x + o1.y * o1.y) + (o1.z * o1.z + o1.w * o1.w);
            ss += __shfl_xor(ss, 1); ss += __shfl_xor(ss, 2); ss += __shfl_xor(ss, 4); ss += __shfl_xor(ss, 8);
            const float rstd = 1.0f / sqrtf(ss * (1.0f / 128.0f) + EPS);
            const size_t off = ((size_t)(b * SEQ + n * 64 + row)) * 1024 + h * 128 + sg * 8;
            float g[8]; unpack8(*(const u32x4*)(GATE + off), g);
            const f32x4 w0 = *(const f32x4*)(a.in[9] + sg * 8), w1 = *(const f32x4*)(a.in[9] + sg * 8 + 4);
            float r[8] = {o0.x * rstd * w0.x * g[0], o0.y * rstd * w0.y * g[1], o0.z * rstd * w0.z * g[2], o0.w * rstd * w0.w * g[3],
                          o1.x * rstd * w1.x * g[4], o1.y * rstd * w1.y * g[5], o1.z * rstd * w1.z * g[6], o1.w * rstd * w1.w * g[7]};
            *(u32x4*)(OB + off) = pack8(r); }
        __syncthreads();
    }
}

constexpr int G_QS = 0, G_KS = 17408, G_KTS = 34816, G_VTS = 53248, G_NB = 71680, G_ATT = 126976, G_VEC = 136192, G_OT = 137472;
constexpr int P128 = 136, P64 = 72;
DI bf16x8 pack_frag_hw(const f32x16& x, int s) { u32x4 p; p.x = pkbf(x[8 * s], x[8 * s + 1]); p.y = pkbf(x[8 * s + 2], x[8 * s + 3]); p.z = pkbf(x[8 * s + 4], x[8 * s + 5]); p.w = pkbf(x[8 * s + 6], x[8 * s + 7]); return __builtin_bit_cast(bf16x8, p); }
DI f32x16 zero16() { f32x16 z;
#pragma unroll
    for (int r = 0; r < 16; ++r) z[r] = 0.f;
    return z; }
DI f32x16 mma_tile(const LAS bf16* A, int lda, const LAS bf16* Bt, int ldb, int ksteps, f32x16 acc, int r32, int hi) {
    for (int s = 0; s < ksteps; ++s) { const bf16x8 af = *(const LAS bf16x8*)(A + r32 * lda + 16 * s + 8 * hi); const bf16x8 bf = *(const LAS bf16x8*)(Bt + r32 * ldb + 16 * s + 8 * hi); acc = MFMA32(af, bf, acc); }
    return acc; }
DI bf16x8 afrag_perm(const LAS bf16* A, int lda, int row, int kb, int hi) { const LAS bf16* p = A + row * lda + kb + 4 * hi; const u32x2 lo = *(const LAS u32x2*)p, h2 = *(const LAS u32x2*)(p + 8);
    u32x4 t; t.x = lo.x; t.y = lo.y; t.z = h2.x; t.w = h2.y; return __builtin_bit_cast(bf16x8, t); }
DI void store_T(LAS bf16* dst, int ld, const f32x16& v, int r32, int hi) {
#pragma unroll
    for (int q = 0; q < 4; ++q) { u32x2 w; w.x = pkbf(v[4 * q], v[4 * q + 1]); w.y = pkbf(v[4 * q + 2], v[4 * q + 3]); *(LAS u32x2*)(dst + r32 * ld + 8 * q + 4 * hi) = w; } }


DI float row16_sum(float x) {
    x += __builtin_bit_cast(float, __builtin_amdgcn_update_dpp(0, __builtin_bit_cast(int, x), 0x128, 0xf, 0xf, false));
    x += __builtin_bit_cast(float, __builtin_amdgcn_update_dpp(0, __builtin_bit_cast(int, x), 0x124, 0xf, 0xf, false));
    x += __builtin_bit_cast(float, __builtin_amdgcn_update_dpp(0, __builtin_bit_cast(int, x), 0x122, 0xf, 0xf, false));
    x += __builtin_bit_cast(float, __builtin_amdgcn_update_dpp(0, __builtin_bit_cast(int, x), 0x121, 0xf, 0xf, false));
    return x; }
DI float lane_read(float v, int srclane) { return __builtin_bit_cast(float, __builtin_amdgcn_ds_bpermute(srclane << 2, __builtin_bit_cast(int, v))); }
DI void store_N(LAS bf16* dst, int ld, const f32x16& v, int r32, int hi) {
#pragma unroll
    for (int q = 0; q < 4; ++q) { const unsigned w0 = pkbf(v[4 * q], v[4 * q + 1]), w1 = pkbf(v[4 * q + 2], v[4 * q + 3]); LAS bf16* p = dst + (8 * q + 4 * hi) * ld + r32;
        p[0] = (bf16)(w0 & 0xffffu); p[ld] = (bf16)(w0 >> 16); p[2 * ld] = (bf16)(w1 & 0xffffu); p[3 * ld] = (bf16)(w1 >> 16); } }
DI unsigned yp_get_(const f32x16 (&R)[4], int r, int c) { const float f = R[r >> 2][4 * (r & 3) + c]; return __builtin_bit_cast(unsigned, f); }
#define YP_GET(R, r, c) yp_get_(R, r, c)
#define YP_SET(R, r, c, v) do { const unsigned yv_ = (unsigned)(v); const float yf_ = __builtin_bit_cast(float, yv_); (R)[(r) >> 2][4 * ((r) & 3) + (c)] = yf_; } while (0)
struct GdnRaw { u32x4 ex[3]; };
DI void gdn_stage_issue(const Args& a, int b, int h, int n, int wave, int lane, GdnRaw& raw, f32x16 (&R)[4]) {
    unsigned char* ws = a.ws;
    if (wave == 4) { const size_t row = (size_t)(b * SEQ + n * 64 + lane); const float* AB = (const float*)(ws + WS_AB); R[0][0] = AB[row * 16 + h]; R[0][1] = AB[row * 16 + 8 + h]; }
    else if (wave >= 5) {
        const int tens = wave - 5, seg = lane & 15, rblk = lane >> 4;
        const bf16* src = (const bf16*)(ws + WS_QB + (size_t)tens * (WS_KB - WS_QB)) + ((size_t)(b * SEQ + n * 64 + rblk * 16)) * 1024 + h * 128 + seg * 8;
        const bool zhalo = (n == 0) && (rblk == 0);
#pragma unroll
        for (int i = 0; i < 19; ++i) { u32x4 v = *(const u32x4*)(src + (ptrdiff_t)(i - 3) * 1024); if (i < 3 && zhalo) v = (u32x4){0u, 0u, 0u, 0u};
            if (i < 16) { YP_SET(R, i, 0, v.x); YP_SET(R, i, 1, v.y); YP_SET(R, i, 2, v.z); YP_SET(R, i, 3, v.w); } else raw.ex[i - 16] = v; }
    }
}
#define RAWROW(i) ((i) < 16 ? (u32x4){YP_GET(R, (i) & 15, 0), YP_GET(R, (i) & 15, 1), YP_GET(R, (i) & 15, 2), YP_GET(R, (i) & 15, 3)} : raw.ex[((i) - 16) < 0 ? 0 : (i) - 16])
template <int HALF> DI void gdn_stage_compute(const Args& a, int h, int wave, int lane, const GdnRaw& raw, f32x16 (&R)[4]) {
    if (wave >= 5) {
        const int tens = wave - 5, seg = lane & 15;
        float cw[4][8];
#pragma unroll
        for (int i = 0; i < 4; ++i) { const float* cp = a.in[6] + (size_t)i * 3072 + tens * 1024 + h * 128 + seg * 8; const f32x4 c0 = *(const f32x4*)cp, c1 = *(const f32x4*)(cp + 4);
            cw[i][0] = c0.x; cw[i][1] = c0.y; cw[i][2] = c0.z; cw[i][3] = c0.w; cw[i][4] = c1.x; cw[i][5] = c1.y; cw[i][6] = c1.z; cw[i][7] = c1.w; }
        float x0[8], x1[8], x2[8], x3[8];
        constexpr int R0 = (HALF == 1) ? 8 : 0, R1 = (HALF == 0) ? 8 : 16;
        unpack8(RAWROW(R0), x0); unpack8(RAWROW(R0 + 1), x1); unpack8(RAWROW(R0 + 2), x2);
#pragma unroll
        for (int r = R0; r < R1; ++r) {
            unpack8(RAWROW(r + 3), x3);
            float y[8]; float ss = 0.f;
#pragma unroll
            for (int j = 0; j < 8; ++j) { float v = cw[0][j] * x0[j] + cw[1][j] * x1[j] + cw[2][j] * x2[j] + cw[3][j] * x3[j];
                v = v * __builtin_amdgcn_rcpf(1.0f + __builtin_amdgcn_exp2f(-1.4426950408889634f * v)); y[j] = v; ss += v * v; x0[j] = x1[j]; x1[j] = x2[j]; x2[j] = x3[j]; }
            if (tens < 2) { ss = row16_sum(ss);
                const float sc = (tens == 0 ? 0.08838834764831845f : 1.0f) * __builtin_amdgcn_rsqf(ss + EPS);
#pragma unroll
                for (int j = 0; j < 8; ++j) y[j] *= sc; }
            YP_SET(R, r, 0, pg8::cvt_pk_bf16(y[0], y[1])); YP_SET(R, r, 1, pg8::cvt_pk_bf16(y[2], y[3])); YP_SET(R, r, 2, pg8::cvt_pk_bf16(y[4], y[5])); YP_SET(R, r, 3, pg8::cvt_pk_bf16(y[6], y[7]));
        }
    }
}
DI unsigned perm_lo(unsigned a, unsigned b) { return (a & 0xffffu) | (b << 16); }
DI unsigned perm_hi(unsigned a, unsigned b) { return (a >> 16) | (b & 0xffff0000u); }
DI void gdn_stage_write(LAS unsigned char* lds, int wave, int lane, const f32x16 (&R)[4]) {
    if (wave == 4) {
        LAS float* vec = (LAS float*)(lds + G_VEC);
        float gc = R[0][0];
#pragma unroll
        for (int o = 1; o < 64; o <<= 1) { const float t = lane_read(gc, lane - o); if (lane >= o) gc += t; }
        const float gl = lane_read(gc, 63);
        vec[lane] = gc; vec[64 + lane] = R[0][1]; vec[128 + lane] = __expf(gc); vec[192 + lane] = __expf(gl - gc); if (lane == 0) vec[256] = __expf(gl);
    } else if (wave >= 5) {
        const int tens = wave - 5, seg = lane & 15, rblk = lane >> 4;
        if (tens < 2) { LAS bf16* dst = (LAS bf16*)(lds + (tens == 0 ? G_QS : G_KS)) + (rblk * 16) * P128 + seg * 8;
#pragma unroll
            for (int r = 0; r < 16; ++r) *(LAS u32x4*)(dst + r * P128) = (u32x4){YP_GET(R, r, 0), YP_GET(R, r, 1), YP_GET(R, r, 2), YP_GET(R, r, 3)}; }
        if (tens >= 1) { LAS bf16* dst = (LAS bf16*)(lds + (tens == 1 ? G_KTS : G_VTS)) + (seg * 8) * P64 + rblk * 16;
#pragma unroll
            for (int jp = 0; jp < 4; ++jp) {
                unsigned lo[8], hi2[8];
#pragma unroll
                for (int rp = 0; rp < 8; ++rp) { const unsigned a0 = YP_GET(R, 2 * rp, jp), a1 = YP_GET(R, 2 * rp + 1, jp); lo[rp] = perm_lo(a0, a1); hi2[rp] = perm_hi(a0, a1); }
                *(LAS u32x4*)(dst + (2 * jp) * P64) = (u32x4){lo[0], lo[1], lo[2], lo[3]}; *(LAS u32x4*)(dst + (2 * jp) * P64 + 8) = (u32x4){lo[4], lo[5], lo[6], lo[7]};
                *(LAS u32x4*)(dst + (2 * jp + 1) * P64) = (u32x4){hi2[0], hi2[1], hi2[2], hi2[3]}; *(LAS u32x4*)(dst + (2 * jp + 1) * P64 + 8) = (u32x4){hi2[4], hi2[5], hi2[6], hi2[7]};
            } }
    }
}

DI void gdn_output(const Args& a, int b, int h, int nchunk, int ltid, const LAS bf16* OT, const u32x4 (&gq)[8], bf16* OB) {
    const int sg = ltid & 15, rw = ltid >> 4;
    const f32x4 w0 = *(const f32x4*)(a.in[9] + sg * 8), w1 = *(const f32x4*)(a.in[9] + sg * 8 + 4);
    const float nw[8] = {w0.x, w0.y, w0.z, w0.w, w1.x, w1.y, w1.z, w1.w};
#pragma unroll
    for (int it = 0; it < 8; ++it) { float o[8], g8[8]; unpack8(*(const LAS u32x4*)(OT + (rw + 8 * it) * P128 + sg * 8), o);
        float ss = 0.f;
#pragma unroll
        for (int e = 0; e < 8; ++e) ss += o[e] * o[e];
        ss = row16_sum(ss);
        const float rstd = __builtin_amdgcn_rsqf(ss * (1.0f / 128.0f) + EPS);
        unpack8(gq[it], g8);
#pragma unroll
        for (int e = 0; e < 8; ++e) o[e] = o[e] * rstd * nw[e] * g8[e];
        *(u32x4*)(OB + ((size_t)(b * SEQ + nchunk * 64 + rw + 8 * it)) * 1024 + h * 128 + sg * 8) = pack8(o); }
}
DI void gdn_gate_prefetch(const Args& a, int b, int h, int nchunk, int ltid, u32x4 (&gq)[8]) {
    const bf16* GATE = (const bf16*)a.out + (size_t)M * DM; const int sg = ltid & 15, rw = ltid >> 4;
#pragma unroll
    for (int it = 0; it < 8; ++it) gq[it] = *(const u32x4*)(GATE + ((size_t)(b * SEQ + nchunk * 64 + rw + 8 * it)) * 1024 + h * 128 + sg * 8);
}
DI int gdn_chunked(const Args& a, int bh, LAS unsigned char* lds, int wave, int lane, bf16* OBdst) {
    int failcode = 0; const int ctid = wave * 64 + lane; const int cc = ctid & 63, cpart = ctid >> 6; (void)cc; (void)cpart;
    const int b = bh >> 3, h = bh & 7; const int lane0 = lane;
    unsigned char* ws = a.ws;
#define GDN_OPAQUE_LANE() int lane = lane0; asm volatile("" : "+v"(lane)); const int r32 = lane & 31, hi = lane >> 5; (void)r32; (void)hi
    LAS bf16* Qs = (LAS bf16*)(lds + G_QS); LAS bf16* Ks = (LAS bf16*)(lds + G_KS); LAS bf16* KTs = (LAS bf16*)(lds + G_KTS); LAS bf16* VTs = (LAS bf16*)(lds + G_VTS);
    LAS bf16* NB = (LAS bf16*)(lds + G_NB); LAS bf16* ATT = (LAS bf16*)(lds + G_ATT); LAS bf16* OT = (LAS bf16*)(lds + G_OT);
    LAS float* VGC = (LAS float*)(lds + G_VEC); LAS float* VBE = VGC + 64; LAS float* VEG = VGC + 128; LAS float* VDL = VGC + 192;
    constexpr int NBQ = 9216 / 2;
    f32x16 Sacc[4];
#pragma unroll
    for (int k = 0; k < 4; ++k) Sacc[k] = zero16();
    GdnRaw raw;
    gdn_stage_issue(a, b, h, 0, wave, lane0, raw, Sacc);
    gdn_stage_compute<2>(a, h, wave, lane0, raw, Sacc);
    gdn_stage_write(lds, wave, lane0, Sacc);
    if (GDN_NCHUNK > 1) gdn_stage_issue(a, b, h, 1, wave, lane0, raw, Sacc);
    __syncthreads();
    if (wave < 4) {
#pragma unroll
        for (int k = 0; k < 4; ++k) Sacc[k] = zero16(); }

    u32x4 gq[8];
    for (int n = 0; n < GDN_NCHUNK; ++n) {
        for (int pa_ = (MK_PROBE == 23) ? 0 : 1; pa_ < 2; ++pa_) {
        if (wave < 2) {
            GDN_OPAQUE_LANE();
            const int d = wave, blk = (32 * d) * P64 + 32 * d;
            {
                f32x16 acc = mma_tile(Ks + 32 * d * P128, P128, Ks + 32 * d * P128, P128, 8, zero16(), r32, hi);
                const int jj = 32 * d + r32; const float gj = VGC[jj];
#pragma unroll
                for (int q = 0; q < 4; ++q) { const int i0 = 32 * d + 8 * q + 4 * hi; const f32x4 gi = *(const LAS f32x4*)(VGC + i0), bei = *(const LAS f32x4*)(VBE + i0);
#pragma unroll
                    for (int e = 0; e < 4; ++e) acc[4 * q + e] = (i0 + e > jj) ? -bei[e] * acc[4 * q + e] * __expf(gi[e] - gj) : 0.f; }
                store_T(NB + 2 * NBQ + blk, P64, acc, r32, hi);
            }
            {
                f32x16 acc = mma_tile(Ks + 32 * d * P128, P128, Ks + 32 * d * P128, P128, 8, zero16(), r32, hi);
                const int ii = 32 * d + r32; const float gi = VGC[ii], bei = VBE[ii]; f32x16 p0;
#pragma unroll
                for (int q = 0; q < 4; ++q) { const int j0 = 32 * d + 8 * q + 4 * hi; const f32x4 gj = *(const LAS f32x4*)(VGC + j0);
#pragma unroll
                    for (int e = 0; e < 4; ++e) { const int jj = j0 + e; const float v = (ii > jj) ? -bei * acc[4 * q + e] * __expf(gi - gj[e]) : 0.f; acc[4 * q + e] = v; p0[4 * q + e] = v + ((ii == jj) ? 1.0f : 0.f); } }
                store_T(NB + blk, P64, acc, r32, hi); store_T(NB + 4 * NBQ + blk, P64, p0, r32, hi);
            }
            asm volatile("s_waitcnt lgkmcnt(0)" ::: "memory");
#pragma unroll 1
            for (int rd = 1; rd <= 5; ++rd) {
                const int qs = (rd - 1) & 1, qd = rd & 1, ps = rd & 1, pd = (rd & 1) ^ 1;
                const LAS bf16* Qn_s = NB + qs * NBQ + blk; const LAS bf16* Qt_s = NB + (2 + qs) * NBQ + blk; const LAS bf16* Pn_s = NB + (4 + ps) * NBQ + blk;
                LAS bf16* Qn_d = NB + qd * NBQ + blk; LAS bf16* Qt_d = NB + (2 + qd) * NBQ + blk; LAS bf16* Pn_d = NB + (4 + pd) * NBQ + blk;
                const bf16x8 qt0 = *(const LAS bf16x8*)(Qt_s + r32 * P64 + 8 * hi), qt1 = *(const LAS bf16x8*)(Qt_s + r32 * P64 + 16 + 8 * hi);
                const bf16x8 qn0 = *(const LAS bf16x8*)(Qn_s + r32 * P64 + 8 * hi), qn1 = *(const LAS bf16x8*)(Qn_s + r32 * P64 + 16 + 8 * hi);
                const bf16x8 pn0 = *(const LAS bf16x8*)(Pn_s + r32 * P64 + 8 * hi), pn1 = *(const LAS bf16x8*)(Pn_s + r32 * P64 + 16 + 8 * hi);
                u32x2 pv[4];
#pragma unroll
                for (int q = 0; q < 4; ++q) pv[q] = *(const LAS u32x2*)(Pn_s + r32 * P64 + 8 * q + 4 * hi);
                f32x16 a0 = zero16(), a1 = zero16(), a2 = zero16();
                if (rd <= 4) { a0 = MFMA32(qt0, qn0, a0); a1 = MFMA32(qn0, qt0, a1); }
                if (rd >= 2) a2 = MFMA32(qt0, pn0, a2);
                if (rd <= 4) { a0 = MFMA32(qt1, qn1, a0); a1 = MFMA32(qn1, qt1, a1); }
                if (rd >= 2) a2 = MFMA32(qt1, pn1, a2);
                if (rd <= 4) { store_T(Qn_d, P64, a0, r32, hi); store_T(Qt_d, P64, a1, r32, hi); }
                if (rd >= 2) {
#pragma unroll
                    for (int q = 0; q < 4; ++q) { a2[4 * q] += bflo(pv[q].x); a2[4 * q + 1] += bfhi(pv[q].x); a2[4 * q + 2] += bflo(pv[q].y); a2[4 * q + 3] += bfhi(pv[q].y); }
                    store_T(Pn_d, P64, a2, r32, hi); }
                asm volatile("s_waitcnt lgkmcnt(0)" ::: "memory");
            }
        } else if (wave == 2) {
            GDN_OPAQUE_LANE();
            f32x16 acc = mma_tile(Ks, P128, Ks + 32 * P128, P128, 8, zero16(), r32, hi);
            const int ii = 32 + r32; const float gi = VGC[ii], bei = VBE[ii];
#pragma unroll
            for (int q = 0; q < 4; ++q) { const int j0 = 8 * q + 4 * hi; const f32x4 gj = *(const LAS f32x4*)(VGC + j0);
#pragma unroll
                for (int e = 0; e < 4; ++e) acc[4 * q + e] = -bei * acc[4 * q + e] * __expf(gi - gj[e]); }
            store_T(NB + 32 * P64, P64, acc, r32, hi);
        }
        if (wave >= 2 && wave < 5) {
            GDN_OPAQUE_LANE();
            const int bi = (wave == 3) ? 0 : 1, bj = (wave == 2) ? 1 : 0;
            f32x16 acc = mma_tile(Ks + 32 * bj * P128, P128, Qs + 32 * bi * P128, P128, 8, zero16(), r32, hi);
            const int ii = 32 * bi + r32; const float gi = VGC[ii];
#pragma unroll
            for (int q = 0; q < 4; ++q) { const int j0 = 32 * bj + 8 * q + 4 * hi; const f32x4 gj = *(const LAS f32x4*)(VGC + j0);
#pragma unroll
                for (int e = 0; e < 4; ++e) acc[4 * q + e] = (ii >= j0 + e) ? acc[4 * q + e] * __expf(gi - gj[e]) : 0.f; }
            store_T(ATT + (32 * bi) * P64 + 32 * bj, P64, acc, r32, hi);
        }
        if ((wave == 2 || wave == 3) && n > 0) { GDN_OPAQUE_LANE(); gdn_output(a, b, h, n - 1, (wave - 2) * 64 + lane, OT, gq, OBdst); }
        if (pa_ == 0) __syncthreads();
        }
        if (wave >= 5 && n + 1 < GDN_NCHUNK) { GDN_OPAQUE_LANE(); gdn_stage_compute<0>(a, h, wave, lane, raw, Sacc); }
        __syncthreads();
        const LAS bf16* Tm = NB + 4 * NBQ;
        if (wave < 4) {
          for (int sc_ = (MK_PROBE == 26) ? 0 : 1; sc_ < 2; ++sc_) {
            GDN_OPAQUE_LANE();
            const int dv0 = 32 * wave;
            bf16x8 sf[8];
#pragma unroll
            for (int s = 0; s < 8; ++s) sf[s] = pack_frag_hw(Sacc[s >> 1], s & 1);
            f32x16 X[2], OQ[2];
#pragma unroll
            for (int mi = 0; mi < 2; ++mi) { X[mi] = zero16(); OQ[mi] = zero16();
#pragma unroll
                for (int s = 0; s < 8; ++s) { X[mi] = MFMA32(afrag_perm(Ks, P128, 32 * mi + r32, 16 * s, hi), sf[s], X[mi]); OQ[mi] = MFMA32(afrag_perm(Qs, P128, 32 * mi + r32, 16 * s, hi), sf[s], OQ[mi]); } }
#pragma unroll
            for (int mi = 0; mi < 2; ++mi)
#pragma unroll
                for (int q = 0; q < 4; ++q) { const int c0 = 32 * mi + 8 * q + 4 * hi; const f32x4 b4 = *(const LAS f32x4*)(VBE + c0), e4 = *(const LAS f32x4*)(VEG + c0);
                    const u32x2 vv = *(const LAS u32x2*)(VTs + (dv0 + r32) * P64 + c0); const float v4[4] = {bflo(vv.x), bfhi(vv.x), bflo(vv.y), bfhi(vv.y)};
#pragma unroll
                    for (int e = 0; e < 4; ++e) { X[mi][4 * q + e] = b4[e] * (v4[e] - e4[e] * X[mi][4 * q + e]); OQ[mi][4 * q + e] *= e4[e]; } }
            f32x16 VN[2];
            { const bf16x8 y00 = pack_frag_hw(X[0], 0), y01 = pack_frag_hw(X[0], 1), y10 = pack_frag_hw(X[1], 0), y11 = pack_frag_hw(X[1], 1);
              VN[0] = MFMA32(afrag_perm(Tm, P64, r32, 0, hi), y00, zero16()); VN[0] = MFMA32(afrag_perm(Tm, P64, r32, 16, hi), y01, VN[0]);
              const bf16x8 n00 = pack_frag_hw(VN[0], 0), n01 = pack_frag_hw(VN[0], 1);
              f32x16 Z = MFMA32(afrag_perm(NB, P64, 32 + r32, 0, hi), n00, X[1]); Z = MFMA32(afrag_perm(NB, P64, 32 + r32, 16, hi), n01, Z);
              const bf16x8 z0 = pack_frag_hw(Z, 0), z1 = pack_frag_hw(Z, 1);
              VN[1] = MFMA32(afrag_perm(Tm, P64, 32 + r32, 32, hi), z0, zero16()); VN[1] = MFMA32(afrag_perm(Tm, P64, 32 + r32, 48, hi), z1, VN[1]); (void)y10; (void)y11; }
            { const bf16x8 v00 = pack_frag_hw(VN[0], 0), v01 = pack_frag_hw(VN[0], 1), v10 = pack_frag_hw(VN[1], 0), v11 = pack_frag_hw(VN[1], 1);
              OQ[0] = MFMA32(afrag_perm(ATT, P64, r32, 0, hi), v00, OQ[0]); OQ[0] = MFMA32(afrag_perm(ATT, P64, r32, 16, hi), v01, OQ[0]);
              OQ[1] = MFMA32(afrag_perm(ATT, P64, 32 + r32, 0, hi), v00, OQ[1]); OQ[1] = MFMA32(afrag_perm(ATT, P64, 32 + r32, 16, hi), v01, OQ[1]);
              OQ[1] = MFMA32(afrag_perm(ATT, P64, 32 + r32, 32, hi), v10, OQ[1]); OQ[1] = MFMA32(afrag_perm(ATT, P64, 32 + r32, 48, hi), v11, OQ[1]); }
#pragma unroll
            for (int mi = 0; mi < 2; ++mi)
#pragma unroll
                for (int q = 0; q < 4; ++q) { const f32x4 d4 = *(const LAS f32x4*)(VDL + 32 * mi + 8 * q + 4 * hi);
#pragma unroll
                    for (int e = 0; e < 4; ++e) VN[mi][4 * q + e] *= d4[e]; }
            if (sc_ == 1) { const float egl = VGC[256];
              const bf16x8 w0 = pack_frag_hw(VN[0], 0), w1 = pack_frag_hw(VN[0], 1), w2 = pack_frag_hw(VN[1], 0), w3 = pack_frag_hw(VN[1], 1);
#pragma unroll
              for (int kb = 0; kb < 4; ++kb) {
#pragma unroll
                  for (int r = 0; r < 16; ++r) Sacc[kb][r] *= egl;
                  Sacc[kb] = MFMA32(afrag_perm(KTs, P64, 32 * kb + r32, 0, hi), w0, Sacc[kb]); Sacc[kb] = MFMA32(afrag_perm(KTs, P64, 32 * kb + r32, 16, hi), w1, Sacc[kb]);
                  Sacc[kb] = MFMA32(afrag_perm(KTs, P64, 32 * kb + r32, 32, hi), w2, Sacc[kb]); Sacc[kb] = MFMA32(afrag_perm(KTs, P64, 32 * kb + r32, 48, hi), w3, Sacc[kb]); } }
            store_N(OT + dv0, P128, OQ[0], r32, hi); store_N(OT + 32 * P128 + dv0, P128, OQ[1], r32, hi);
          }
        } else {
            GDN_OPAQUE_LANE();
            if (wave >= 5 && n + 1 < GDN_NCHUNK) gdn_stage_compute<1>(a, h, wave, lane, raw, Sacc);
        }
        __syncthreads();

        if (wave == 2 || wave == 3) { GDN_OPAQUE_LANE(); gdn_gate_prefetch(a, b, h, n, (wave - 2) * 64 + lane, gq); }
        for (int pd_ = (MK_PROBE == 25) ? 0 : 1; pd_ < 2; ++pd_) {
        if (wave >= 4 && n + 1 < GDN_NCHUNK) { GDN_OPAQUE_LANE(); gdn_stage_write(lds, wave, lane, Sacc); if (n + 2 < GDN_NCHUNK && pd_ == 1) gdn_stage_issue(a, b, h, n + 2, wave, lane, raw, Sacc); }
        if (pd_ == 0) __syncthreads();
        }
        __syncthreads();
    }
    if (wave == 2 || wave == 3) { GDN_OPAQUE_LANE(); gdn_output(a, b, h, GDN_NCHUNK - 1, (wave - 2) * 64 + lane, OT, gq, OBdst); }
    __syncthreads();
    return failcode;
}

DI unsigned sortable(float f) { const unsigned u = __builtin_bit_cast(unsigned, f); return (u & 0x80000000u) ? ~u : (u | 0x80000000u); }
DI float unsortable(unsigned k) { const unsigned u = (k & 0x80000000u) ? (k & 0x7fffffffu) : ~k; return __builtin_bit_cast(float, u); }
#define CE_DESC(x, y) do { const unsigned _a = (x), _b = (y); (x) = _a > _b ? _a : _b; (y) = _a > _b ? _b : _a; } while (0)
#define CE_ASC(x, y) do { const unsigned _a = (x), _b = (y); (x) = _a > _b ? _b : _a; (y) = _a > _b ? _a : _b; } while (0)
DI void sort16_desc(unsigned (&v)[16]) { CE_DESC(v[0], v[1]); CE_DESC(v[2], v[3]); CE_DESC(v[0], v[2]); CE_DESC(v[1], v[3]); CE_DESC(v[1], v[2]); CE_DESC(v[4], v[5]); CE_DESC(v[6], v[7]); CE_DESC(v[4], v[6]); CE_DESC(v[5], v[7]); CE_DESC(v[5], v[6]); CE_DESC(v[0], v[4]); CE_DESC(v[2], v[6]); CE_DESC(v[2], v[4]); CE_DESC(v[1], v[5]); CE_DESC(v[3], v[7]); CE_DESC(v[3], v[5]); CE_DESC(v[1], v[2]); CE_DESC(v[3], v[4]); CE_DESC(v[5], v[6]); CE_DESC(v[8], v[9]); CE_DESC(v[10], v[11]); CE_DESC(v[8], v[10]); CE_DESC(v[9], v[11]); CE_DESC(v[9], v[10]); CE_DESC(v[12], v[13]); CE_DESC(v[14], v[15]); CE_DESC(v[12], v[14]); CE_DESC(v[13], v[15]); CE_DESC(v[13], v[14]); CE_DESC(v[8], v[12]); CE_DESC(v[10], v[14]); CE_DESC(v[10], v[12]); CE_DESC(v[9], v[13]); CE_DESC(v[11], v[15]); CE_DESC(v[11], v[13]); CE_DESC(v[9], v[10]); CE_DESC(v[11], v[12]); CE_DESC(v[13], v[14]); CE_DESC(v[0], v[8]); CE_DESC(v[4], v[12]); CE_DESC(v[4], v[8]); CE_DESC(v[2], v[10]); CE_DESC(v[6], v[14]); CE_DESC(v[6], v[10]); CE_DESC(v[2], v[4]); CE_DESC(v[6], v[8]); CE_DESC(v[10], v[12]); CE_DESC(v[1], v[9]); CE_DESC(v[5], v[13]); CE_DESC(v[5], v[9]); CE_DESC(v[3], v[11]); CE_DESC(v[7], v[15]); CE_DESC(v[7], v[11]); CE_DESC(v[3], v[5]); CE_DESC(v[7], v[9]); CE_DESC(v[11], v[13]); CE_DESC(v[1], v[2]); CE_DESC(v[3], v[4]); CE_DESC(v[5], v[6]); CE_DESC(v[7], v[8]); CE_DESC(v[9], v[10]); CE_DESC(v[11], v[12]); CE_DESC(v[13], v[14]); }
DI void merge8x8_desc(unsigned (&v)[16]) { CE_DESC(v[0], v[8]); CE_DESC(v[4], v[12]); CE_DESC(v[4], v[8]); CE_DESC(v[2], v[10]); CE_DESC(v[6], v[14]); CE_DESC(v[6], v[10]); CE_DESC(v[2], v[4]); CE_DESC(v[6], v[8]); CE_DESC(v[10], v[12]); CE_DESC(v[1], v[9]); CE_DESC(v[5], v[13]); CE_DESC(v[5], v[9]); CE_DESC(v[3], v[11]); CE_DESC(v[7], v[15]); CE_DESC(v[7], v[11]); CE_DESC(v[3], v[5]); CE_DESC(v[7], v[9]); CE_DESC(v[11], v[13]); CE_DESC(v[1], v[2]); CE_DESC(v[3], v[4]); CE_DESC(v[5], v[6]); CE_DESC(v[7], v[8]); CE_DESC(v[9], v[10]); CE_DESC(v[11], v[12]); CE_DESC(v[13], v[14]); }
DI void bitonic_merge16_desc(unsigned (&v)[16]) {
#pragma unroll
    for (int j = 8; j > 0; j >>= 1)
#pragma unroll
        for (int i = 0; i < 16; ++i) { const int l = i ^ j; if (l > i) CE_DESC(v[i], v[l]); }
}
DI void merge_top16(unsigned (&x)[16], const unsigned (&y)[16]) {
#pragma unroll
    for (int i = 0; i < 16; ++i) x[i] = x[i] > y[15 - i] ? x[i] : y[15 - i];
    bitonic_merge16_desc(x);
}
DI void merge_top16_2(unsigned (&x)[16], unsigned y0, unsigned y1) { CE_DESC(x[0], y0); CE_DESC(x[8], y0); CE_DESC(x[4], x[8]); CE_DESC(x[12], y0); CE_DESC(x[6], x[10]); CE_DESC(x[2], x[4]); CE_DESC(x[6], x[8]); CE_DESC(x[10], x[12]); CE_DESC(x[14], y0); CE_DESC(x[1], y1); CE_DESC(x[9], y1); CE_DESC(x[5], x[9]); CE_DESC(x[13], y1); CE_DESC(x[7], x[11]); CE_DESC(x[3], x[5]); CE_DESC(x[7], x[9]); CE_DESC(x[11], x[13]); x[15] = x[15] > y1 ? x[15] : y1; CE_DESC(x[1], x[2]); CE_DESC(x[3], x[4]); CE_DESC(x[5], x[6]); CE_DESC(x[7], x[8]); CE_DESC(x[9], x[10]); CE_DESC(x[11], x[12]); CE_DESC(x[13], x[14]); x[15] = x[15] > y0 ? x[15] : y0;  }
DI void top16_of_64(const unsigned (&x)[64], unsigned (&out)[16]) {
    unsigned g[4][16];
#pragma unroll
    for (int q = 0; q < 4; ++q) {
#pragma unroll
        for (int i = 0; i < 16; ++i) g[q][i] = x[16 * q + i];
        sort16_desc(g[q]); }
    merge_top16(g[0], g[1]); merge_top16(g[2], g[3]); merge_top16(g[0], g[2]);
#pragma unroll
    for (int i = 0; i < 16; ++i) out[i] = g[0][i];
}
DI float gelu_exact(float x) { return 0.5f * x * (1.0f + erff(x * 0.7071067811865476f)); }

DI void route_scores_issue(const unsigned char* ws, int tile, int p, int head, int lane, LAS unsigned char* sbuf) {
    const char* gp = (const char*)(ws + WS_QP) + ((size_t)(tile * 32 + (lane & 31)) * 2048 + head * 256 + p * 128 + 64 * (lane >> 5)) * 2;
#pragma unroll
    for (int c8 = 0; c8 < 8; ++c8) __builtin_amdgcn_global_load_lds((const unsigned*)(gp + 16 * c8), (LAS unsigned*)(sbuf + c8 * 1024), 16, 0, 0);
}
DI void peer_route_tile(const Args& a, int tile, int q4, LAS unsigned char* lds, int wave, int lane_in) {
    int lane = lane_in; asm volatile("" : "+v"(lane));
    const int r32 = lane & 31, hi = lane >> 5, head = wave;
    unsigned char* ws = a.ws;
    LAS unsigned short* EIDX = (LAS unsigned short*)lds;
    LAS unsigned short* GATEH = (LAS unsigned short*)(lds + 32768);
    LAS unsigned char* scr = lds + 65536 + wave * 2048;
    LAS unsigned char* sbuf = lds + 81920 + wave * 8192;
    const float* SSQ = (const float*)(ws + WS_SSQ);
    const int token = tile * 32 + r32;
    float rstd;
    { const f32x4* sp = (const f32x4*)(SSQ + (size_t)token * 16); const f32x4 s0 = sp[0], s1 = sp[1], s2 = sp[2], s3 = sp[3];
      const float ssq = ((s0.x + s0.y) + (s0.z + s0.w)) + ((s1.x + s1.y) + (s1.z + s1.w)) + ((s2.x + s2.y) + (s2.z + s2.w)) + ((s3.x + s3.y) + (s3.z + s3.w));
      rstd = 1.0f / sqrtf(ssq * (1.0f / DM) + EPS); }
    unsigned top[2][16];
#pragma unroll
    for (int p = 0; p < 2; ++p) {
        unsigned key[64];
        u32x4 raw[8];
        asm volatile("s_waitcnt vmcnt(0)" ::: "memory");
#pragma unroll
        for (int c8 = 0; c8 < 8; ++c8) raw[c8] = *(const LAS u32x4*)(sbuf + c8 * 1024 + lane * 16);
        asm volatile("s_waitcnt lgkmcnt(0)" ::: "memory");
        if (!(q4 == 3 && p == 1)) route_scores_issue(ws, p == 0 ? tile : tile + 1, p ^ 1, head, lane, sbuf);
#pragma unroll
        for (int c8 = 0; c8 < 8; ++c8) { float f[8]; unpack8(raw[c8], f);
#pragma unroll
            for (int e = 0; e < 8; ++e) key[8 * c8 + e] = (sortable(f[e]) & ~127u) | (unsigned)(127 - (64 * hi + 8 * c8 + e)); }
        unsigned t16[16], o16[16];
        top16_of_64(key, t16);
#pragma unroll
        for (int i = 0; i < 16; ++i) o16[i] = (unsigned)__shfl_xor((int)t16[i], 32);
        merge_top16(t16, o16);
#pragma unroll
        for (int i = 0; i < 16; ++i) top[p][i] = t16[i];
    }
    unsigned tc[16];
    {
        float A[16], B[16];
#pragma unroll
        for (int i = 0; i < 16; ++i) { A[i] = unsortable(top[0][i] & ~127u); B[i] = unsortable(top[1][i] & ~127u); }
#define CKEY(aa, bb) ((sortable(A[aa] + B[bb]) & ~255u) | (unsigned)(255 - ((aa) * 16 + (bb))))
        unsigned G1[16], G2[16];
#pragma unroll
        for (int b = 0; b < 16; ++b) tc[b] = CKEY(0, b);
#pragma unroll
        for (int b = 0; b < 8; ++b) { G1[b] = CKEY(1, b); G1[8 + b] = CKEY(8 + b, 0); }
        merge8x8_desc(G1);
        G2[0] = CKEY(2, 0); G2[1] = CKEY(2, 1); G2[2] = CKEY(2, 2); G2[3] = CKEY(2, 3); G2[4] = CKEY(2, 4); G2[5] = CKEY(3, 0); G2[6] = CKEY(3, 1); G2[7] = CKEY(3, 2); G2[8] = CKEY(3, 3);
        G2[9] = CKEY(4, 0); G2[10] = CKEY(4, 1); G2[11] = CKEY(4, 2); G2[12] = CKEY(5, 0); G2[13] = CKEY(5, 1); G2[14] = CKEY(6, 0); G2[15] = CKEY(6, 1);
        sort16_desc(G2);
        merge_top16_2(G2, CKEY(7, 0), CKEY(7, 1));
        merge_top16(tc, G1); merge_top16(tc, G2);
#undef CKEY
    }
    float gt[16];
    { float sv[16]; float sum = 0.f;
#pragma unroll
      for (int i = 0; i < 16; ++i) sv[i] = unsortable(tc[i] & ~255u) * rstd;
#pragma unroll
      for (int i = 0; i < 16; ++i) { gt[i] = __expf(sv[i] - sv[0]); sum += gt[i]; }
      const float inv = 1.0f / sum;
#pragma unroll
      for (int i = 0; i < 16; ++i) gt[i] *= inv; }
    { LAS unsigned* sw = (LAS unsigned*)(scr + lane * 32);
#pragma unroll
      for (int p = 0; p < 2; ++p)
#pragma unroll
          for (int q = 0; q < 4; ++q) sw[p * 4 + q] = (~top[p][4 * q] & 127u) | ((~top[p][4 * q + 1] & 127u) << 8) | ((~top[p][4 * q + 2] & 127u) << 16) | ((~top[p][4 * q + 3] & 127u) << 24);
      asm volatile("s_waitcnt lgkmcnt(0)" ::: "memory");
#pragma unroll
      for (int i = 0; i < 16; ++i) { const unsigned pos = ~tc[i] & 255u; const unsigned i1 = scr[lane * 32 + (pos >> 4)], i2 = scr[lane * 32 + 16 + (pos & 15u)];
          if (hi == 0) { EIDX[(q4 * 32 + r32) * 128 + head * 16 + i] = (unsigned short)(i1 * 128u + i2); GATEH[(q4 * 32 + r32) * 128 + head * 16 + i] = (unsigned short)f2bf(gt[i]); } }
    }
    asm volatile("s_waitcnt lgkmcnt(0)" ::: "memory");
}

DI float dot2bf(unsigned w, unsigned x, float acc) { return __builtin_amdgcn_fdot2_f32_bf16(__builtin_bit_cast(bf16x2_t, w), __builtin_bit_cast(bf16x2_t, x), acc, false); }
#define DPP_I(x, ctrl) __builtin_amdgcn_update_dpp(0, (x), (ctrl), 0xf, 0xf, false)
DI void peer_group(const Args& a, int grp, LAS unsigned char* lds, int wave, int lane, bool dry) {
    unsigned char* ws = a.ws;
    LAS unsigned short* EIDX = (LAS unsigned short*)lds;
    LAS unsigned short* GATEH = (LAS unsigned short*)(lds + 32768);
    LAS int* DOTI = (LAS int*)(lds + 65536);
    LAS float* DOTS = (LAS float*)(lds + 65536);
    const float* SSQ = (const float*)(ws + WS_SSQ);
    for (int rr_ = (MK_PROBE == 70) ? 0 : 1; rr_ < 2; ++rr_)
    { if (rr_ == ((MK_PROBE == 70) ? 0 : 1)) {} route_scores_issue(ws, grp * 4, 0, wave, lane, lds + 81920 + wave * 8192);
    for (int q4 = 0; q4 < 4; ++q4) peer_route_tile(a, grp * 4 + q4, q4, lds, wave, lane); }
    __syncthreads();
    const int tl0 = wave * 16, g = lane >> 3, j = lane & 7;
    for (int dd_ = (MK_PROBE == 71) ? 0 : 1; dd_ < 2; ++dd_) {
#pragma unroll
    for (int i = 0; i < 8; ++i) *(LAS u32x4*)(DOTI + tl0 * 128 + i * 256 + lane * 4) = (u32x4){0u, 0u, 0u, 0u};
    asm volatile("s_waitcnt lgkmcnt(0)" ::: "memory");
    for (int sp = 0; sp < 8; ++sp) {
        const __amdgpu_buffer_rsrc_t rs = __builtin_amdgcn_make_buffer_rsrc((void*)(ws + WS_DOWN + (size_t)sp * (2 * MiB)), (short)0, (int)(2 * MiB), 0x00020000);
        for (int i = 0; i < 16; ++i) {
            const int tl = tl0 + i; const size_t tok = (size_t)grp * 128 + tl;
            const u32x4 xq = *(const u32x4*)(ws + WS_X2Q + tok * 1024 + 128 * sp + 16 * j);
            u32x4 r[16];
#pragma unroll
            for (int ii = 0; ii < 16; ++ii) r[ii] = bload16(rs, (unsigned)EIDX[tl * 128 + 8 * ii + g] * 128u + 16u * j);
            int part0 = 0, part1 = 0;
#pragma unroll
            for (int ii = 0; ii < 16; ++ii) {
                int p = __builtin_amdgcn_sdot4((int)r[ii].x, (int)xq.x, 0, false); p = __builtin_amdgcn_sdot4((int)r[ii].y, (int)xq.y, p, false);
                p = __builtin_amdgcn_sdot4((int)r[ii].z, (int)xq.z, p, false); p = __builtin_amdgcn_sdot4((int)r[ii].w, (int)xq.w, p, false);
                p += DPP_I(p, 0xB1); p += DPP_I(p, 0x4E); p += DPP_I(p, 0x141);
                if (ii < 8) part0 += ((ii & 7) == j) ? p : 0; else part1 += ((ii & 7) == j) ? p : 0;
            }
            LAS int* dp = DOTI + tl * 128 + 8 * j + g;
            dp[0] += part0; dp[64] += part1;
        }
    }
    }
    asm volatile("s_waitcnt lgkmcnt(0)" ::: "memory");
    for (int i = 0; i < 16; ++i) {
        const int tl = tl0 + i; const size_t tok = (size_t)grp * 128 + tl;
        const float rstd_t = 1.0f / sqrtf(wave_sum(lane < 16 ? SSQ[tok * 16 + lane] : 0.f) * (1.0f / DM) + EPS) * ((const float*)(ws + WS_XSC))[tok];
#pragma unroll
        for (int q = 0; q < 2; ++q) { const int sl = tl * 128 + 64 * q + lane; const unsigned e = EIDX[sl];
            const float d = (float)DOTI[sl] * ((const float*)(ws + WS_DSC))[e] * rstd_t;
            DOTS[sl] = bflo((unsigned)GATEH[sl]) * gelu_exact(d) * ((const float*)(ws + WS_USC))[e]; }
    }
    asm volatile("s_waitcnt lgkmcnt(0)" ::: "memory");
    for (int uu_ = (MK_PROBE == 72) ? 0 : 1; uu_ < 2; ++uu_)
    for (int sp = 0; sp < 8; ++sp) {
        const __amdgpu_buffer_rsrc_t rs = __builtin_amdgcn_make_buffer_rsrc((void*)(ws + WS_UP + (size_t)sp * (2 * MiB)), (short)0, (int)(2 * MiB), 0x00020000);
        for (int i = 0; i < 16; ++i) {
            const int tl = tl0 + i; const size_t tok = (size_t)grp * 128 + tl;
            u32x4 r[16]; float cf[16];
            const bf16* xp = (const bf16*)(ws + WS_X2B) + tok * 1024 + 128 * sp + 16 * j;
            const u32x4 xr0 = *(const u32x4*)xp, xr1 = *(const u32x4*)(xp + 8);
#pragma unroll
            for (int ii = 0; ii < 16; ++ii) { r[ii] = bload16(rs, (unsigned)EIDX[tl * 128 + 8 * ii + g] * 128u + 16u * j); cf[ii] = DOTS[tl * 128 + 8 * ii + g]; }
            float acc[16];
#pragma unroll
            for (int k = 0; k < 16; ++k) acc[k] = 0.f;
#pragma unroll
            for (int ii = 0; ii < 16; ++ii) {
                const unsigned w[4] = {r[ii].x, r[ii].y, r[ii].z, r[ii].w};
#pragma unroll
                for (int k = 0; k < 4; ++k) { const f32x2v lo = __builtin_amdgcn_cvt_pk_f32_fp8((int)w[k], false), hi2 = __builtin_amdgcn_cvt_pk_f32_fp8((int)w[k], true);
                    acc[4 * k] += cf[ii] * lo.x; acc[4 * k + 1] += cf[ii] * lo.y; acc[4 * k + 2] += cf[ii] * hi2.x; acc[4 * k + 3] += cf[ii] * hi2.y; } }
#pragma unroll
            for (int k = 0; k < 16; ++k) { acc[k] += __builtin_bit_cast(float, DPP_I(__builtin_bit_cast(int, acc[k]), 0x128)); acc[k] += __shfl_xor(acc[k], 16); acc[k] += __shfl_xor(acc[k], 32); }
            if (g == 0 && !dry && uu_ == 1) { float* op = a.out + tok * 1024 + 128 * sp + 16 * j;
                float x2a[8], x2b[8]; unpack8(xr0, x2a); unpack8(xr1, x2b);
#pragma unroll
                for (int k = 0; k < 2; ++k) { *(f32x4*)(op + 4 * k) = (f32x4){x2a[4 * k] + acc[4 * k], x2a[4 * k + 1] + acc[4 * k + 1], x2a[4 * k + 2] + acc[4 * k + 2], x2a[4 * k + 3] + acc[4 * k + 3]};
                    *(f32x4*)(op + 8 + 4 * k) = (f32x4){x2b[4 * k] + acc[8 + 4 * k], x2b[4 * k + 1] + acc[8 + 4 * k + 1], x2b[4 * k + 2] + acc[8 + 4 * k + 2], x2b[4 * k + 3] + acc[8 + 4 * k + 3]}; } }
        }
    }
    __syncthreads();
}

DI float wave_max(float v) {
#pragma unroll
    for (int o = 1; o < 64; o <<= 1) v = fmaxf(v, __shfl_xor(v, o));
    return v; }
DI void peer_table_rows(const Args& a, int gw, int NGW, int lane, int rbeg, int rend) {
    for (int r0 = rbeg + gw * 4; r0 < rend; r0 += NGW * 4) {
        const bool dn = r0 < NEXP; const int e0 = dn ? r0 : r0 - NEXP;
        const float* srcb = (dn ? a.in[18] : a.in[19]) + (size_t)e0 * 1024;
        f32x4 v[4][2][2];
#pragma unroll
        for (int q = 0; q < 4; ++q)
#pragma unroll
            for (int j = 0; j < 2; ++j) { const int c = j * 512 + 8 * lane; v[q][j][0] = *(const f32x4*)(srcb + q * 1024 + c); v[q][j][1] = *(const f32x4*)(srcb + q * 1024 + c + 4); }
        f32x4 w[2][2];
#pragma unroll
        for (int j = 0; j < 2; ++j) { const int c = j * 512 + 8 * lane; w[j][0] = dn ? *(const f32x4*)(a.in[14] + c) : (f32x4){1.f, 1.f, 1.f, 1.f}; w[j][1] = dn ? *(const f32x4*)(a.in[14] + c + 4) : (f32x4){1.f, 1.f, 1.f, 1.f}; }
#pragma unroll
        for (int q = 0; q < 4; ++q) {
            float mx = 0.f;
#pragma unroll
            for (int j = 0; j < 2; ++j)
#pragma unroll
                for (int k = 0; k < 2; ++k) { v[q][j][k] *= w[j][k]; mx = fmaxf(mx, fmaxf(fmaxf(fabsf(v[q][j][k].x), fabsf(v[q][j][k].y)), fmaxf(fabsf(v[q][j][k].z), fabsf(v[q][j][k].w)))); }
            mx = wave_max(mx);
            const float sc = mx > 0.f ? mx * (dn ? (1.0f / 127.0f) : (1.0f / 416.0f)) : 1.0f, inv = 1.0f / sc; const int e = e0 + q;
            if (lane == 0) ((float*)(a.ws + (dn ? WS_DSC : WS_USC)))[e] = sc;
#pragma unroll
            for (int j = 0; j < 2; ++j) { const int c = j * 512 + 8 * lane; unsigned w0, w1;
                const f32x4 p = v[q][j][0] * inv, t = v[q][j][1] * inv;
                if (dn) { w0 = ((unsigned)(int)rintf(p.x) & 255u) | (((unsigned)(int)rintf(p.y) & 255u) << 8) | (((unsigned)(int)rintf(p.z) & 255u) << 16) | (((unsigned)(int)rintf(p.w) & 255u) << 24);
                          w1 = ((unsigned)(int)rintf(t.x) & 255u) | (((unsigned)(int)rintf(t.y) & 255u) << 8) | (((unsigned)(int)rintf(t.z) & 255u) << 16) | (((unsigned)(int)rintf(t.w) & 255u) << 24); }
                else { int t0 = __builtin_amdgcn_cvt_pk_fp8_f32(p.x, p.y, 0, false); t0 = __builtin_amdgcn_cvt_pk_fp8_f32(p.z, p.w, t0, true);
                       int t1 = __builtin_amdgcn_cvt_pk_fp8_f32(t.x, t.y, 0, false); t1 = __builtin_amdgcn_cvt_pk_fp8_f32(t.z, t.w, t1, true); w0 = (unsigned)t0; w1 = (unsigned)t1; }
                *(u32x2*)(a.ws + (dn ? WS_DOWN : WS_UP) + ((size_t)(c >> 7) * NEXP + e) * 128 + (c & 127)) = (u32x2){w0, w1}; }
        }
    }
}
DI void wk_quant_rows(const Args& a, int gw, int NGW, int lane) {
    for (int r = gw; r < 2048; r += NGW) {
        const bf16* src = (const bf16*)(a.ws + WS_WQ) + (size_t)r * 1024 + 16 * lane;
        float f0[8], f1[8]; unpack8(*(const u32x4*)src, f0); unpack8(*(const u32x4*)(src + 8), f1);
        float mx = 0.f;
#pragma unroll
        for (int e = 0; e < 8; ++e) mx = fmaxf(mx, fmaxf(fabsf(f0[e]), fabsf(f1[e])));
        mx = wave_max(mx);
        const float sc = mx > 0.f ? mx * (1.0f / 127.0f) : 1.0f, inv = 1.0f / sc;
        if (lane == 0) ((float*)(a.ws + WS_WKSC))[r] = sc;
        u32x4 w;
#define Q4(x0, x1, x2, x3) (((unsigned)(int)rintf((x0) * inv) & 255u) | (((unsigned)(int)rintf((x1) * inv) & 255u) << 8) | (((unsigned)(int)rintf((x2) * inv) & 255u) << 16) | (((unsigned)(int)rintf((x3) * inv) & 255u) << 24))
        w.x = Q4(f0[0], f0[1], f0[2], f0[3]); w.y = Q4(f0[4], f0[5], f0[6], f0[7]); w.z = Q4(f1[0], f1[1], f1[2], f1[3]); w.w = Q4(f1[4], f1[5], f1[6], f1[7]);
#undef Q4
        *(u32x4*)(a.ws + WS_WK8 + (size_t)r * 1024 + 16 * lane) = w;
    }
}
DI void x2_quant_rows(const Args& a, int gw, int NGW, int lane) {
    for (int m0 = gw * 4; m0 < M; m0 += NGW * 4) {
        f32x4 v[4][4];
#pragma unroll
        for (int q = 0; q < 4; ++q) { const u32x2* xr = (const u32x2*)((const bf16*)(a.ws + WS_X2B) + (size_t)(m0 + q) * DM) + lane;
#pragma unroll
            for (int j = 0; j < 4; ++j) { const u32x2 w = xr[64 * j]; v[q][j] = (f32x4){__builtin_bit_cast(float, w.x << 16), __builtin_bit_cast(float, w.x & 0xffff0000u), __builtin_bit_cast(float, w.y << 16), __builtin_bit_cast(float, w.y & 0xffff0000u)}; } }
#pragma unroll
        for (int q = 0; q < 4; ++q) { float mx = 0.f;
#pragma unroll
            for (int j = 0; j < 4; ++j) mx = fmaxf(mx, fmaxf(fmaxf(fabsf(v[q][j].x), fabsf(v[q][j].y)), fmaxf(fabsf(v[q][j].z), fabsf(v[q][j].w))));
            mx = wave_max(mx);
            const float sc = mx > 0.f ? mx * (1.0f / 127.0f) : 1.0f, inv = 1.0f / sc;
            if (lane == 0) ((float*)(a.ws + WS_XSC))[m0 + q] = sc;
            unsigned* o = (unsigned*)(a.ws + WS_X2Q + (size_t)(m0 + q) * DM) + lane;
#pragma unroll
            for (int j = 0; j < 4; ++j) { const f32x4 p = v[q][j] * inv;
                o[64 * j] = ((unsigned)(int)rintf(p.x) & 255u) | (((unsigned)(int)rintf(p.y) & 255u) << 8) | (((unsigned)(int)rintf(p.z) & 255u) << 16) | (((unsigned)(int)rintf(p.w) & 255u) << 24); } }
    }
}

#define XB_TMO      128
#define XB_XCNT(j)  (256  + 64 * (j))
#define XB_XSUB(j)  (1280 + 64 * (j))
#define XB_XGEN(j)  (2304 + 64 * (j))
#define XB_TOP      3328
#define XB_TOPGEN   3392
#define XCD_BAR_WORDS 3456
#define XB_SPIN_CAP (1u << 22)
DI unsigned xb_ld(unsigned* p)              { return __hip_atomic_load(p, __ATOMIC_RELAXED, __HIP_MEMORY_SCOPE_AGENT); }
DI unsigned xb_add(unsigned* p, unsigned v) { return __hip_atomic_fetch_add(p, v, __ATOMIC_RELAXED, __HIP_MEMORY_SCOPE_AGENT); }
DI unsigned xb_xcc_id() { return (unsigned)__builtin_amdgcn_s_getreg((3 << 11) | 20) & 0xFu; }
#define XB_SPIN(cond, bar) do { unsigned _sp = 0; while (cond) { __builtin_amdgcn_s_sleep(1); \
    if ((++_sp & 255u) == 0u) { if (xb_ld(&(bar)[XB_TMO])) break; if (_sp > XB_SPIN_CAP) { atomicAdd(&(bar)[XB_TMO], 1u); break; } } } } while (0)
DI void xcd_barrier_complete(unsigned* bar, unsigned x, unsigned& nloc, unsigned& nx) {
    const unsigned G = gridDim.x * gridDim.y * gridDim.z;
    unsigned sum, cnt, mine, sp = 0u;
    for (;;) {
        sum = 0u; cnt = 0u; mine = 0u;
#pragma unroll
        for (unsigned j = 0; j < 16; ++j) { const unsigned c = xb_ld(&bar[XB_XCNT(j)]); sum += c; cnt += (c > 0u) ? 1u : 0u; mine = (j == x) ? c : mine; }
        if (sum == G) break;
        __builtin_amdgcn_s_sleep(1);
        if ((++sp & 255u) == 0u) { if (xb_ld(&bar[XB_TMO])) break; if (sp > XB_SPIN_CAP) { atomicAdd(&bar[XB_TMO], 1u); break; } }
    }
    nloc = mine > 0u ? mine : 1u; nx = cnt > 0u ? cnt : 1u;
}
DI void xcd_barrier(unsigned* bar, volatile LAS unsigned* st, bool leader) {
    asm volatile("s_waitcnt vmcnt(0)" ::: "memory");
    __syncthreads();
    if (leader) {
        const unsigned x = xb_xcc_id();
        __builtin_amdgcn_s_waitcnt(0);
        unsigned nloc = st[0], nx = st[1];
        if (nloc == 0u) { xcd_barrier_complete(bar, x, nloc, nx); st[0] = nloc; st[1] = nx; }
        const unsigned old = xb_add(&bar[XB_XSUB(x)], 1u);
        const unsigned gen = old / nloc;
        if (old + 1u == (gen + 1u) * nloc) {
            __builtin_amdgcn_fence(__ATOMIC_RELEASE, "agent");
            asm volatile("s_waitcnt vmcnt(0)" ::: "memory");
            const unsigned og = xb_add(&bar[XB_TOP], 1u);
            const unsigned tg = og / nx;
            if (og + 1u == (tg + 1u) * nx) xb_add(&bar[XB_TOPGEN], 1u);
            else XB_SPIN(xb_ld(&bar[XB_TOPGEN]) == tg, bar);
            __builtin_amdgcn_fence(__ATOMIC_ACQUIRE, "agent");
            xb_add(&bar[XB_XGEN(x)], 1u);
            asm volatile("s_waitcnt vmcnt(0)" ::: "memory");
        } else {
            XB_SPIN(xb_ld(&bar[XB_XGEN(x)]) == gen, bar);
            __builtin_amdgcn_fence(__ATOMIC_ACQUIRE, "agent");
            asm volatile("s_waitcnt vmcnt(0)" ::: "memory");
        }
    }
    __syncthreads();
}
#if GDN_CMP
__global__ void __launch_bounds__(NTHREADS, 2) gdn_v1_kernel(Args a) {
    extern __shared__ __attribute__((aligned(16))) unsigned char lds_raw2[];
    gdn_seq(a, blockIdx.x, (LAS unsigned char*)lds_raw2, threadIdx.x);
}
#endif
#if GDN_CMP
__global__ void __launch_bounds__(NTHREADS, 2) gdn_v2_dbg_kernel(Args a) {
    extern __shared__ __attribute__((aligned(16))) unsigned char lds_raw3[];
    LAS unsigned char* lds = (LAS unsigned char*)lds_raw3; unsigned char* ws = a.ws;
    const int tid = threadIdx.x, lane = tid & 63, wave = __builtin_amdgcn_readfirstlane(tid >> 6), bh = blockIdx.x;
                const int fcode = gdn_chunked(a, bh, lds, wave, lane, (bf16*)a.out);
                __syncthreads();
                { const bf16* O1 = (const bf16*)(ws + WS_OB); const bf16* O2 = (const bf16*)a.out; float sd = 0.f, sr = 0.f;
                  for (int e = tid; e < (GDN_CMP_T1 - GDN_CMP_T0) * 128; e += NTHREADS) { const size_t off = ((size_t)((bh >> 3) * SEQ + GDN_CMP_T0 + (e >> 7))) * 1024 + (bh & 7) * 128 + (e & 127);
                      const float r1 = bflo((unsigned)O1[off]), d = r1 - bflo((unsigned)O2[off]); sd += d * d; sr += r1 * r1; }
                  sd = wave_sum(sd); sr = wave_sum(sr);
                  LAS float* red = (LAS float*)lds; if (lane == 0) { red[wave] = sd; red[8 + wave] = sr; } __syncthreads();
                  float ad = 0.f, ar = 0.f; for (int w2 = 0; w2 < 8; ++w2) { ad += red[w2]; ar += red[8 + w2]; }
                  if (ad > GDN_CMP_THR * ar || fcode) { const unsigned pz = fcode == 1 ? 0x47c3u : (fcode == 2 ? 0x461cu : (fcode == 3 ? 0x447au : (fcode == 4 ? 0x42c8u : 0x4120u))); bf16* O1w = (bf16*)(ws + WS_OB); for (int e = tid; e < 64 * 128; e += NTHREADS) O1w[((size_t)((bh >> 3) * SEQ + (e >> 7))) * 1024 + (bh & 7) * 128 + (e & 127)] = (bf16)pz; }
                  __syncthreads(); }
}
#endif
DI int lane_id_opaque() { int l = (int)__builtin_amdgcn_mbcnt_hi(~0u, __builtin_amdgcn_mbcnt_lo(~0u, 0u)); asm volatile("" : "+v"(l)); return l; }
__global__ void __launch_bounds__(NTHREADS, 2) fwd_kernel(Args a_in) {
    extern __shared__ __attribute__((aligned(16))) unsigned char lds_raw[];
    LAS unsigned char* lds = (LAS unsigned char*)lds_raw;
    int wave_ = __builtin_amdgcn_readfirstlane((int)threadIdx.x >> 6); asm volatile("" : "+s"(wave_));
    const int wave = wave_;
#define LANE_ID() lane_id_opaque()
    const int G = gridDim.x, bx = blockIdx.x;
    const int gw = bx * NWAVES + wave, NGW = G * NWAVES;
#define FRESH_ARGS() const __attribute__((address_space(4))) Args* kp_ = (const __attribute__((address_space(4))) Args*)__builtin_amdgcn_kernarg_segment_ptr(); asm volatile("" : "+s"(kp_)); Args a; _Pragma("unroll") for (int i_ = 0; i_ < 20; ++i_) a.in[i_] = kp_->in[i_]; a.out = kp_->out; a.ws = kp_->ws; a.ph_lo = kp_->ph_lo; a.ph_hi = kp_->ph_hi; a.probe = kp_->probe; a.dry = kp_->dry; unsigned char* ws = a.ws; (void)ws
    volatile LAS unsigned* bar_st = (volatile LAS unsigned*)(lds + LDS_BYTES - 64);
#if MK_ONE_LAUNCH
    { const int l0 = LANE_ID(); if (wave == 0 && l0 < 2) bar_st[l0] = 0u; __syncthreads();
      if (wave == 0 && l0 == 0) (void)xb_add((unsigned*)(a_in.ws + WS_CTL) + XB_XCNT(xb_xcc_id()), 1u); }
#define GRID_BAR() do { FRESH_ARGS(); xcd_barrier((unsigned*)(a.ws + WS_CTL), bar_st, wave == 0 && LANE_ID() == 0); } while (0)
#else
#define GRID_BAR() do {} while (0)
#endif
    const int lo = a_in.ph_lo, hi = a_in.ph_hi;
#define IN(k) (lo <= (k) && (k) < hi)
#define SEAM(k) do { if (IN(k) && IN((k) + 1) && !((k) == 3 && G >= 256)) GRID_BAR(); } while (0)
    typedef pg8::bf16_t pbf;
#define REP(k) for (int rep_ = (MK_PROBE == (k)) ? 0 : 1; rep_ < 2; ++rep_)
    if (IN(0)) REP(0) { FRESH_ARGS(); phase0(a, lds, gw, NGW, wave, LANE_ID()); }
    SEAM(0);
    if (IN(1)) REP(1) {
        FRESH_ARGS();
        wk_quant_rows(a, gw, NGW, LANE_ID());
#if P1_FP8
        {
            pg8::Gemm g{(const pbf*)(ws + WS_H8), (const pbf*)(ws + WS_W8), M, P1_FP8_UPTO, 512}; pg8::StaticOrder S; S.init(M, P1_FP8_UPTO, G, bx);
            pg8::EpiIn E{ws, (pbf*)a.out + (size_t)M * DM, a.in[10], a.in[7], a.in[8], 0};
            pg8::gemm_phase<pg8::EpiIn, pg8::StaticOrder, true, true, true>(lds, g, S, E, wave);
        }
        if (P1_FP8_UPTO < NIN - 256) {
            pg8::Gemm g{(const pbf*)a.out, (const pbf*)(ws + WS_WIN) + (size_t)P1_FP8_UPTO * 1024, M, NIN - 256 - P1_FP8_UPTO, 1024}; pg8::StaticOrder S; S.init(M, NIN - 256 - P1_FP8_UPTO, G, bx);
            pg8::EpiIn E{ws, (pbf*)a.out + (size_t)M * DM, a.in[10], a.in[7], a.in[8], P1_FP8_UPTO / 256};
            pg8::gemm_phase<pg8::EpiIn, pg8::StaticOrder, true, true, false>(lds, g, S, E, wave);
        }
#else
        { pg8::Gemm g{(const pbf*)a.out, (const pbf*)(ws + WS_WIN), M, NIN - 256, 1024}; pg8::StaticOrder S; S.init(M, NIN - 256, G, bx);
          pg8::EpiIn E{ws, (pbf*)a.out + (size_t)M * DM, a.in[10], a.in[7], a.in[8], 0};
          pg8::gemm_phase<pg8::EpiIn, pg8::StaticOrder, true, true, false>(lds, g, S, E, wave); }
#endif
    }
    SEAM(1);
    if (IN(2)) REP(2) {
        __syncthreads();
        if (bx < 128 || G < 256) {
            for (int grep_ = (MK_PROBE == 20) ? 0 : 1; grep_ < 2; ++grep_)
            for (int bh = bx; bh < 128; bh += (G < 256 ? G : 128)) {
                FRESH_ARGS();
#if GDN_V1
                gdn_seq(a, bh, lds, wave * 64 + LANE_ID());
#elif GDN_CMP
                (void)bh;
#else
                gdn_chunked(a, bh, lds, wave, LANE_ID(), (bf16*)(ws + WS_OB));
#endif
            }
        }
        if (G >= 256) {
            if (bx >= 128) {
                { FRESH_ARGS(); peer_table_rows(a, (bx - 128) * 8 + wave, 1024, LANE_ID(), 0, TBL_P2_ROWS); }
                const int pm = bx - 128;
                for (int arep_ = (MK_PROBE == 22) ? 0 : 1; arep_ < 2; ++arep_)
                for (int i4 = 0; i4 < 4; ++i4) { FRESH_ARGS(); const bool dry = (rep_ == 0) || (arep_ == 0) || (a.dry != 0); attn_unit(a, pm >> 3, 4 * (pm & 7) + i4, lds + wave * 18432, wave, LANE_ID(), dry); }
                asm volatile("s_waitcnt vmcnt(0)" ::: "memory"); __syncthreads();
                if (wave == 0) { __builtin_amdgcn_fence(__ATOMIC_RELEASE, "agent"); __builtin_amdgcn_fence(__ATOMIC_ACQUIRE, "agent"); asm volatile("s_waitcnt vmcnt(0)" ::: "memory"); }
                __syncthreads();
                { FRESH_ARGS();
                  pg8::Gemm g{(const pbf*)(ws + WS_QA), (const pbf*)(ws + WS_WPA), M, 1024, 512}; pg8::RowTileOrder S{pm, 4};
                  pg8::EpiMix<false> E{(pbf*)a.out, ws + WS_MERGE, nullptr};
                  pg8::gemm_phase<pg8::EpiMix<false>, pg8::RowTileOrder, true, true>(lds, g, S, E, wave); }
            }
        }
        __syncthreads();
    }
    SEAM(2);
    SEAM(3);
    if (IN(4)) {
        FRESH_ARGS();
        pg8::Gemm g{(const pbf*)(ws + WS_OB), (const pbf*)(ws + WS_WPB), M, 1024, 1024}; pg8::StaticOrder S; S.init(M, 1024, G, bx);
        pg8::EpiMix<true> E{(pbf*)(ws + WS_MIXED), ws + WS_MERGE + 1024, (const pbf*)a.out};
        pg8::gemm_phase<pg8::EpiMix<true>, pg8::StaticOrder, true, true>(lds, g, S, E, wave);
    }
    SEAM(4);
    if (IN(5)) REP(5) {
        FRESH_ARGS();
        peer_table_rows(a, gw, NGW, LANE_ID(), TBL_P2_ROWS, 2 * NEXP);
        { pg8::Gemm g{(const pbf*)(ws + WS_MIXED), (const pbf*)(ws + WS_WOUT), M, 1024, 1024}; pg8::StaticOrder S; S.init(M, 1024, G, bx);
          pg8::EpiOut E{a.in[0], a.out, (pbf*)(ws + WS_X2B), (float*)(ws + WS_SSQ)};
          pg8::gemm_phase<pg8::EpiOut, pg8::StaticOrder, true, true>(lds, g, S, E, wave); }
    }
    SEAM(5);
    if (IN(6)) REP(6) {
        FRESH_ARGS();
        x2_quant_rows(a, gw, NGW, LANE_ID());
        GRID_BAR();
        { FRESH_ARGS();
          pg8::Gemm g{(const pbf*)(ws + WS_X2Q), (const pbf*)(ws + WS_WK8), M, 2048, 512}; pg8::StaticOrder S; S.init(M, 2048, G, bx);
          pg8::EpiScore E{(pbf*)(ws + WS_QP), (const float*)(ws + WS_XSC), (const float*)(ws + WS_WKSC)};
          pg8::gemm_phase<pg8::EpiScore, pg8::StaticOrder, true, true, false, true>(lds, g, S, E, wave); }
    }
    SEAM(6);
    if (IN(7)) REP(7) {
        __syncthreads();
        for (int t = bx; t < M / 128; t += G) { FRESH_ARGS(); const bool dry = (rep_ == 0) || (a.dry != 0); peer_group(a, t, lds, wave, LANE_ID(), dry); }
    }
#undef IN
#undef SEAM
}

extern "C" void kernel_launch(void* const* d_in, const int* in_sizes, int n_in, void* d_out, int out_size, void* d_ws, size_t ws_size, hipStream_t stream) {
    static int grid = 0;
    if (grid == 0) {
        if (n_in != 20 || out_size != M * DM || ws_size < WS_END) { fprintf(stderr, "kernel_launch: unexpected problem (n_in %d, out %d, ws %zu); nothing launched\n", n_in, out_size, ws_size); grid = -1; return; }
        int dev = 0, cus = 0, per_cu = 0;
        if (hipGetDevice(&dev) != hipSuccess || hipDeviceGetAttribute(&cus, hipDeviceAttributeMultiprocessorCount, dev) != hipSuccess) { grid = -1; return; }
        if (hipFuncSetAttribute((const void*)fwd_kernel, hipFuncAttributeMaxDynamicSharedMemorySize, LDS_BYTES) != hipSuccess) { fprintf(stderr, "kernel_launch: hipFuncSetAttribute failed\n"); grid = -1; return; }
        if (hipOccupancyMaxActiveBlocksPerMultiprocessor(&per_cu, (const void*)fwd_kernel, NTHREADS, LDS_BYTES) != hipSuccess || per_cu < 1) { fprintf(stderr, "kernel_launch: occupancy query says %d\n", per_cu); per_cu = 1; }
        (void)hipGetLastError();
        grid = cus;
        if (grid != 256) { fprintf(stderr, "kernel_launch: this kernel is built for a 256-CU device (got %d)\n", grid); grid = 256; }
    }
    if (grid < 0) return;
    (void)hipMemsetAsync((char*)d_ws + WS_CTL, 0, CTL_ZERO_BYTES, stream);
    Args a{};
    for (int i = 0; i < 20; ++i) a.in[i] = (const float*)d_in[i];
    a.out = (float*)d_out; a.ws = (unsigned char*)d_ws; a.probe = MK_PROBE; a.dry = 0;
#if MK_ONE_LAUNCH
    a.ph_lo = 0; a.ph_hi = N_PHASES;
    void* args[] = {&a};
    hipError_t e = hipLaunchCooperativeKernel((const void*)fwd_kernel, dim3(grid), dim3(NTHREADS), args, LDS_BYTES, stream);
    if (e != hipSuccess) fprintf(stderr, "kernel_launch: cooperative launch failed: %s (grid %d)\n", hipGetErrorString(e), grid);
#else
    for (int p = 0; p < N_PHASES; ++p) {
#if GDN_CMP
        if (p == 2) { (void)hipFuncSetAttribute((const void*)gdn_v1_kernel, hipFuncAttributeMaxDynamicSharedMemorySize, LDS_BYTES); hipLaunchKernelGGL(gdn_v1_kernel, dim3(128), dim3(NTHREADS), LDS_BYTES, stream, a);
            (void)hipFuncSetAttribute((const void*)gdn_v2_dbg_kernel, hipFuncAttributeMaxDynamicSharedMemorySize, LDS_BYTES); hipLaunchKernelGGL(gdn_v2_dbg_kernel, dim3(128), dim3(NTHREADS), LDS_BYTES, stream, a); }
#endif
        a.ph_lo = p; a.ph_hi = p + 1;
        hipLaunchKernelGGL(fwd_kernel, dim3(grid), dim3(NTHREADS), LDS_BYTES, stream, a);
    }
#endif
}
```
